# Optimizing an MI355X kernel written in HIP

```python
import math
import jax, jax.numpy as jnp
from jax import lax
import numpy as np

D_MODEL = 1024
BATCH = 4
SEQ = 4096
DEPTH = 2

EPS = 1e-6
D_MIX = D_MODEL
LRU_WIDTH = D_MIX // 2
LRU_BLOCKS = 8
LRU_BLOCK_W = LRU_WIDTH // LRU_BLOCKS
LRU_C = 8.0
CONV_W = 4
N_HEADS = 8
QK_NOPE = 64
QK_ROPE = 32
V_HEAD = 64
Q_LORA = 256
KV_LORA = 128
ROPE_THETA = 10000.0
Q_BLOCK = 128
IN_SPLITS = (LRU_WIDTH, 2 * LRU_WIDTH, 2 * LRU_WIDTH + Q_LORA,
             2 * LRU_WIDTH + Q_LORA + KV_LORA)
IN_COLS = 2 * LRU_WIDTH + Q_LORA + KV_LORA + QK_ROPE
D_FF_DENSE = 2816
N_EXPERTS = 8
TOP_K = 2
D_FF_EXPERT = 1792
N_DENSE = (DEPTH + 1) // 2
N_MOE = DEPTH // 2

kernel_name = "hymba_rglru_mla_moe_trunk"


def rmsnorm(x, g):
    xf = x.astype(jnp.float32)
    y = xf * lax.rsqrt(jnp.mean(xf * xf, axis=-1, keepdims=True) + EPS)
    return (y * g.astype(jnp.float32)).astype(x.dtype)


def rope_tables(positions):
    half = QK_ROPE // 2
    inv = 1.0 / (ROPE_THETA ** (jnp.arange(half, dtype=jnp.float32) / half))
    ang = positions.astype(jnp.float32)[..., None] * inv
    return jnp.cos(ang), jnp.sin(ang)


def apply_rope(x, cos, sin):
    xf = x.astype(jnp.float32)
    x1, x2 = xf[..., : QK_ROPE // 2], xf[..., QK_ROPE // 2:]
    out = jnp.concatenate([x1 * cos - x2 * sin, x2 * cos + x1 * sin], axis=-1)
    return out.astype(x.dtype)


def causal_depthwise_conv(x, w, b):
    y = lax.conv_general_dilated(
        x, w[:, None, :].astype(x.dtype), window_strides=(1,),
        padding=((CONV_W - 1, 0),), dimension_numbers=("NWC", "WIO", "NWC"),
        feature_group_count=x.shape[-1])
    return y + b


def rg_lru(x, wa, ba, wx, bx, lam):
    B, S, C = x.shape
    xb = x.reshape(B, S, LRU_BLOCKS, LRU_BLOCK_W)
    r = jax.nn.sigmoid(jnp.einsum("bsnc,ncd->bsnd", xb, wa) + ba).reshape(B, S, C)
    i = jax.nn.sigmoid(jnp.einsum("bsnc,ncd->bsnd", xb, wx) + bx).reshape(B, S, C)
    log_a = -LRU_C * r.astype(jnp.float32) * jax.nn.softplus(-lam.astype(jnp.float32))
    a = jnp.exp(log_a)
    mult = jnp.sqrt(-jnp.expm1(2.0 * log_a))
    mult = jnp.where((jnp.arange(S) == 0)[None, :, None], jnp.float32(1.0), mult)
    u = mult * (i * x).astype(jnp.float32)

    def combine(left, right):
        a_l, b_l = left
        a_r, b_r = right
        return a_l * a_r, a_r * b_l + b_r

    _, h = lax.associative_scan(combine, (a, u), axis=1)
    return h.astype(x.dtype)


def mla_causal_attention(q_nope, q_rope, k_nope, k_rope, v):
    B, S, H, _ = q_nope.shape
    nb = S // Q_BLOCK
    scale = 1.0 / math.sqrt(QK_NOPE + QK_ROPE)
    qn = q_nope.reshape(B, nb, Q_BLOCK, H, QK_NOPE).transpose(1, 0, 2, 3, 4)
    qr = q_rope.reshape(B, nb, Q_BLOCK, H, QK_ROPE).transpose(1, 0, 2, 3, 4)
    k_pos = jnp.arange(S)

    def one_block(args):
        qn_b, qr_b, bi = args
        s = (jnp.einsum("bqhd,bkhd->bhqk", qn_b, k_nope, preferred_element_type=jnp.float32)
             + jnp.einsum("bqhd,bkd->bhqk", qr_b, k_rope, preferred_element_type=jnp.float32)) * scale
        q_pos = bi * Q_BLOCK + jnp.arange(Q_BLOCK)
        s = jnp.where((k_pos[None, :] <= q_pos[:, None])[None, None], s, -jnp.inf)
        p = jax.nn.softmax(s, axis=-1)
        return jnp.einsum("bhqk,bkhd->bqhd", p.astype(v.dtype), v)

    o = lax.map(one_block, (qn, qr, jnp.arange(nb)))
    return o.transpose(1, 0, 2, 3, 4).reshape(B, S, H * V_HEAD)


def swiglu(t, wg, wu, wd):
    return (jax.nn.silu(t @ wg) * (t @ wu)) @ wd


def moe_swiglu(h, router_w, wg, wu, wd):
    B, S, D = h.shape
    t = h.reshape(B * S, D)
    logits = (t @ router_w).astype(jnp.float32)
    top_v, top_i = lax.top_k(logits, TOP_K)
    top_w = jax.nn.softmax(top_v, axis=-1)
    gates = jnp.sum(jax.nn.one_hot(top_i, N_EXPERTS, dtype=jnp.float32) * top_w[..., None], axis=1)
    out = jnp.zeros((B * S, D), jnp.float32)
    for e in range(N_EXPERTS):
        out = out + gates[:, e:e + 1] * swiglu(t, wg[e], wu[e], wd[e]).astype(jnp.float32)
    return out.astype(h.dtype).reshape(B, S, D)


def setup_inputs(seed: int = 0) -> dict:
    key = jax.random.key(seed)
    ks = jax.random.split(key, 32)
    f32 = jnp.float32

    def nrm(k, shape, fan_in):
        return jax.random.normal(k, shape, f32) * (fan_in ** -0.5)

    def gain(k, shape):
        return 1.0 + 0.02 * jax.random.normal(k, shape, f32)

    def bias(k, shape):
        return 0.02 * jax.random.normal(k, shape, f32)

    u = jax.random.uniform(ks[10], (DEPTH, LRU_WIDTH), f32, minval=0.9, maxval=0.999)
    a0 = u ** (1.0 / LRU_C)
    lru_lambda = jnp.log(a0) - jnp.log1p(-a0)

    return {
        "x": jax.random.normal(ks[0], (BATCH, SEQ, D_MODEL), f32),
        "positions": jnp.broadcast_to(jnp.arange(SEQ, dtype=jnp.int32), (BATCH, SEQ)),
        "norm_mix": gain(ks[1], (DEPTH, D_MODEL)),
        "w_in": nrm(ks[2], (DEPTH, D_MODEL, IN_COLS), D_MODEL),
        "conv_w": nrm(ks[3], (DEPTH, CONV_W, LRU_WIDTH), CONV_W),
        "conv_b": bias(ks[4], (DEPTH, LRU_WIDTH)),
        "lru_wa": nrm(ks[5], (DEPTH, LRU_BLOCKS, LRU_BLOCK_W, LRU_BLOCK_W), LRU_BLOCK_W),
        "lru_ba": bias(ks[6], (DEPTH, LRU_BLOCKS, LRU_BLOCK_W)),
        "lru_wx": nrm(ks[7], (DEPTH, LRU_BLOCKS, LRU_BLOCK_W, LRU_BLOCK_W), LRU_BLOCK_W),
        "lru_bx": bias(ks[8], (DEPTH, LRU_BLOCKS, LRU_BLOCK_W)),
        "lru_lambda": lru_lambda,
        "q_norm": gain(ks[11], (DEPTH, Q_LORA)),
        "w_uq": nrm(ks[12], (DEPTH, Q_LORA, N_HEADS * (QK_NOPE + QK_ROPE)), Q_LORA),
        "kv_norm": gain(ks[13], (DEPTH, KV_LORA)),
        "w_ukv": nrm(ks[14], (DEPTH, KV_LORA, N_HEADS * (QK_NOPE + V_HEAD)), KV_LORA),
        "w_out": nrm(ks[15], (DEPTH, D_MIX, D_MODEL), D_MIX),
        "norm_ffn": gain(ks[16], (DEPTH, D_MODEL)),
        "dense_w_gate": nrm(ks[17], (N_DENSE, D_MODEL, D_FF_DENSE), D_MODEL),
        "dense_w_up": nrm(ks[18], (N_DENSE, D_MODEL, D_FF_DENSE), D_MODEL),
        "dense_w_down": nrm(ks[19], (N_DENSE, D_FF_DENSE, D_MODEL), D_FF_DENSE),
        "router_w": nrm(ks[20], (N_MOE, D_MODEL, N_EXPERTS), D_MODEL),
        "expert_w_gate": nrm(ks[21], (N_MOE, N_EXPERTS, D_MODEL, D_FF_EXPERT), D_MODEL),
        "expert_w_up": nrm(ks[22], (N_MOE, N_EXPERTS, D_MODEL, D_FF_EXPERT), D_MODEL),
        "expert_w_down": nrm(ks[23], (N_MOE, N_EXPERTS, D_FF_EXPERT, D_MODEL), D_FF_EXPERT),
        "norm_final": gain(ks[24], (D_MODEL,)),
    }


def reference(x, positions, norm_mix, w_in, conv_w, conv_b, lru_wa, lru_ba, lru_wx, lru_bx,
              lru_lambda, q_norm, w_uq, kv_norm, w_ukv, w_out, norm_ffn, dense_w_gate,
              dense_w_up, dense_w_down, router_w, expert_w_gate, expert_w_up, expert_w_down,
              norm_final):
    B, S, _ = x.shape
    cos, sin = rope_tables(positions)
    for l in range(DEPTH):
        h = rmsnorm(x, norm_mix[l])
        z = h @ w_in[l]
        x_lru, y_gate, c_q, c_kv, k_rope = jnp.split(z, IN_SPLITS, axis=-1)

        xc = causal_depthwise_conv(x_lru, conv_w[l], conv_b[l])
        hl = rg_lru(xc, lru_wa[l], lru_ba[l], lru_wx[l], lru_bx[l], lru_lambda[l])
        lru_out = hl * jax.nn.gelu(y_gate)

        q = (rmsnorm(c_q, q_norm[l]) @ w_uq[l]).reshape(B, S, N_HEADS, QK_NOPE + QK_ROPE)
        kv = (rmsnorm(c_kv, kv_norm[l]) @ w_ukv[l]).reshape(B, S, N_HEADS, QK_NOPE + V_HEAD)
        q_nope = q[..., :QK_NOPE]
        q_rope = apply_rope(q[..., QK_NOPE:], cos[:, :, None, :], sin[:, :, None, :])
        k_nope, v = kv[..., :QK_NOPE], kv[..., QK_NOPE:]
        k_rope = apply_rope(k_rope, cos, sin)
        attn_out = mla_causal_attention(q_nope, q_rope, k_nope, k_rope, v)

        x = x + jnp.concatenate([lru_out, attn_out], axis=-1) @ w_out[l]

        h2 = rmsnorm(x, norm_ffn[l])
        if l % 2 == 0:
            j = l // 2
            ffn = swiglu(h2, dense_w_gate[j], dense_w_up[j], dense_w_down[j])
        else:
            j = l // 2
            ffn = moe_swiglu(h2, router_w[j], expert_w_gate[j], expert_w_up[j], expert_w_down[j])
        x = x + ffn
    return rmsnorm(x, norm_final)
```

```cpp
#include <hip/hip_runtime.h>
#include <hip/hip_cooperative_groups.h>
#include <cstdint>
#include <cstdio>
namespace cg = cooperative_groups;

typedef unsigned short bf16_t;
typedef short bf16x8 __attribute__((ext_vector_type(8)));
typedef float f32x4 __attribute__((ext_vector_type(4)));
typedef float f32x16 __attribute__((ext_vector_type(16)));
typedef unsigned u32x4 __attribute__((ext_vector_type(4)));
typedef unsigned u32x2 __attribute__((ext_vector_type(2)));

constexpr int BATCH = 4, SEQ = 4096, T = BATCH * SEQ, DM = 1024, DEPTH = 2;
constexpr int LRU_W = 512, NH = 8, QKN = 64, QKR = 32, VH = 64, QLORA = 256, KVLORA = 128;
constexpr int INC = 1440, INCP = 1536, DQK = QKN + QKR  , QW = NH * DQK  , KVW = NH * (QKN + VH)  ;
constexpr int DFF = 2816, NE = 8, DFE = 1792;
constexpr float EPS = 1e-6f;
constexpr int NTHR = 512, NWAVE = 8;
constexpr int ROWS_MAX = 2 * T + NE * 256;
constexpr float QSCALE = 0.10206207261596577f * 1.4426950408889634f;

constexpr size_t MiB = 1u << 20;
constexpr size_t WS_CTL = 0;
constexpr size_t WS_TAB = 1 * MiB;
constexpr size_t WS_SSX = 3 * MiB;
constexpr size_t WS_SSQ = 5 * MiB;
constexpr size_t WS_SSKV = 5 * MiB + 512 * 1024;
constexpr size_t WS_SUM = 6 * MiB;
constexpr size_t WS_TOPE = 7 * MiB;
constexpr size_t WS_TOPW = WS_TOPE + 128 * 1024;
constexpr size_t WS_RANK = WS_TOPW + 128 * 1024;
constexpr size_t WS_ROWTOK = WS_RANK + 128 * 1024;
constexpr size_t WS_ROWW = WS_ROWTOK + 136 * 1024;
constexpr size_t WS_ROWSLOT = WS_ROWW + 136 * 1024;
constexpr size_t WS_WIN = 8 * MiB;
constexpr size_t WS_WUQ = 14 * MiB;
constexpr size_t WS_WUKV = 15 * MiB;
constexpr size_t WS_WOUT = 16 * MiB;
constexpr size_t WS_WGU = 20 * MiB;
constexpr size_t WS_WD = 31 * MiB;
constexpr size_t WS_XB = 37 * MiB;
constexpr size_t WS_EGU = 69 * MiB;
constexpr size_t WS_ED = 125 * MiB;
constexpr size_t WS_Y = 37 * MiB;
constexpr size_t WS_ACT = 153 * MiB;
constexpr size_t WS_XL = 153 * MiB, WS_GY = 169 * MiB, WS_QF = 185 * MiB, WS_KF = 209 * MiB, WS_VT = 233 * MiB;
constexpr size_t WS_CQ = 249 * MiB, WS_CKV = 257 * MiB, WS_KR = 261 * MiB, WS_MIX = 249 * MiB;
constexpr size_t WS_END = 281 * MiB;

struct P {
    const float *x; const int* positions; const float *norm_mix, *w_in, *conv_w, *conv_b, *lru_wa, *lru_ba, *lru_wx, *lru_bx, *lru_lambda, *q_norm, *w_uq, *kv_norm, *w_ukv,
        *w_out, *norm_ffn, *dense_w_gate, *dense_w_up, *dense_w_down, *router_w, *expert_w_gate, *expert_w_up, *expert_w_down, *norm_final;
    float* out; unsigned char* ws;
};

__device__ __forceinline__ unsigned f2bf(float f) { unsigned u = __builtin_bit_cast(unsigned, f); return (u + 0x7fffu + ((u >> 16) & 1u)) >> 16; }
__device__ __forceinline__ unsigned pk2(float lo, float hi) { return f2bf(lo) | (f2bf(hi) << 16); }
__device__ __forceinline__ float bf2f(unsigned short b) { return __builtin_bit_cast(float, (unsigned)b << 16); }
__device__ __forceinline__ void store4bf(bf16_t* p, f32x4 v) { u32x2 w; w.x = pk2(v[0], v[1]); w.y = pk2(v[2], v[3]); *(u32x2*)p = w; }
__device__ __forceinline__ float sigmoidf_(float x) { return 1.f / (1.f + __expf(-x)); }
__device__ __forceinline__ float gelu_tanh(float x) { const float u = 0.7978845608028654f * (x + 0.044715f * x * x * x); return 0.5f * x * (1.f + tanhf(u)); }
__device__ __forceinline__ float wave_sum(float v) {
#pragma unroll
    for (int o = 1; o < 64; o <<= 1) v += __shfl_xor(v, o);
    return v;
}
__device__ __forceinline__ float row_rs(const float* ss, int row, int nslot, float inv_n) {
    float s = 0.f;
    for (int i = 0; i < nslot; i += 4) { const f32x4 v = *(const f32x4*)(ss + (size_t)row * nslot + i); s += (v[0] + v[1]) + (v[2] + v[3]); }
    return rsqrtf(s * inv_n + EPS);
}

__device__ __forceinline__ void conv_matrix(const float* W, int K, int N, bf16_t* WT, int mode, const float* gain, int gw, int ngw, float* scr, int lane) {
    const int nblk = N / 32, nitems = (K / 64) * nblk;
    for (int item = gw; item < nitems; item += ngw) {
        const int kb = item / nblk, nb = item % nblk, k0 = 64 * kb, n0 = 32 * nb;
#pragma unroll 8
        for (int i = 0; i < 32; ++i) { const int kk = 2 * i + (lane >> 5); float v = W[(size_t)(k0 + kk) * N + n0 + (lane & 31)]; if (gain) v *= gain[k0 + kk]; scr[kk * 33 + (lane & 31)] = v; }
        __builtin_amdgcn_s_waitcnt(0xC07F); asm volatile("" ::: "memory");
        const int c = lane & 7;
#pragma unroll
        for (int j = 0; j < 4; ++j) { const int nl = (lane >> 3) + 8 * j; const float* s = scr + (8 * c) * 33 + nl; const int n = n0 + nl;
            const int drow = mode == 0 ? n : ((n >> 4) * 32 + (n & 15) + (mode == 2 ? 16 : 0));
            u32x4 o; o.x = pk2(s[0 * 33], s[1 * 33]); o.y = pk2(s[2 * 33], s[3 * 33]); o.z = pk2(s[4 * 33], s[5 * 33]); o.w = pk2(s[6 * 33], s[7 * 33]);
            *(u32x4*)(WT + (size_t)drow * K + k0 + 8 * c) = o; }
        __builtin_amdgcn_s_waitcnt(0xC07F); asm volatile("" ::: "memory");
    }
}

__device__ void phase_p0(const P& p, int bid, int nb, unsigned char* smem) {
    const int tid = threadIdx.x, lane = tid & 63, wid = tid >> 6;
    float* scr = (float*)smem + wid * (64 * 33);
    const int gw = bid * NWAVE + wid, ngw = nb * NWAVE;
    unsigned char* ws = p.ws;
    for (int l = 0; l < DEPTH; ++l) {
        conv_matrix(p.w_in + (size_t)l * DM * INC, DM, INC, (bf16_t*)(ws + WS_WIN) + (size_t)l * INCP * DM, 0, p.norm_mix + l * DM, gw, ngw, scr, lane);
        conv_matrix(p.w_uq + (size_t)l * QLORA * QW, QLORA, QW, (bf16_t*)(ws + WS_WUQ) + (size_t)l * QW * QLORA, 0, p.q_norm + l * QLORA, gw, ngw, scr, lane);
        conv_matrix(p.w_ukv + (size_t)l * KVLORA * KVW, KVLORA, KVW, (bf16_t*)(ws + WS_WUKV) + (size_t)l * KVW * KVLORA, 0, p.kv_norm + l * KVLORA, gw, ngw, scr, lane);
        conv_matrix(p.w_out + (size_t)l * DM * DM, DM, DM, (bf16_t*)(ws + WS_WOUT) + (size_t)l * DM * DM, 0, nullptr, gw, ngw, scr, lane);
    }
    conv_matrix(p.dense_w_gate, DM, DFF, (bf16_t*)(ws + WS_WGU), 1, p.norm_ffn, gw, ngw, scr, lane);
    conv_matrix(p.dense_w_up, DM, DFF, (bf16_t*)(ws + WS_WGU), 2, p.norm_ffn, gw, ngw, scr, lane);
    conv_matrix(p.dense_w_down, DFF, DM, (bf16_t*)(ws + WS_WD), 0, nullptr, gw, ngw, scr, lane);
    for (int e = 0; e < NE; ++e) {
        conv_matrix(p.expert_w_gate + (size_t)e * DM * DFE, DM, DFE, (bf16_t*)(ws + WS_EGU) + (size_t)e * 2 * DFE * DM, 1, p.norm_ffn + DM, gw, ngw, scr, lane);
        conv_matrix(p.expert_w_up + (size_t)e * DM * DFE, DM, DFE, (bf16_t*)(ws + WS_EGU) + (size_t)e * 2 * DFE * DM, 2, p.norm_ffn + DM, gw, ngw, scr, lane);
        conv_matrix(p.expert_w_down + (size_t)e * DFE * DM, DFE, DM, (bf16_t*)(ws + WS_ED) + (size_t)e * DM * DFE, 0, nullptr, gw, ngw, scr, lane);
    }
    const int gt = bid * NTHR + tid, ngt = nb * NTHR;
    for (int l = 0; l < DEPTH; ++l) { u32x4* z = (u32x4*)((bf16_t*)(ws + WS_WIN) + ((size_t)l * INCP + INC) * DM); for (int i = gt; i < (INCP - INC) * DM / 8; i += ngt) z[i] = (u32x4){0u, 0u, 0u, 0u}; }
    { float* tab = (float*)(ws + WS_TAB);
      for (int i = gt; i < T * 16; i += ngt) { const int t = i >> 4, f = i & 15; const float inv = 1.0f / powf(10000.0f, (float)f / 16.0f); const float ang = (float)p.positions[t] * inv;
          float s, c; sincosf(ang, &s, &c); tab[2 * i] = c; tab[2 * i + 1] = s; } }
    { int* cnt = (int*)(ws + WS_CTL); if (gt < 64) cnt[gt] = 0;
      int* rt = (int*)(ws + WS_ROWTOK); float* rw = (float*)(ws + WS_ROWW); int* rs = (int*)(ws + WS_ROWSLOT);
      for (int i = gt; i < ROWS_MAX; i += ngt) { rt[i] = 0; rw[i] = 0.f; rs[i] = -1; } }
    { bf16_t* XB = (bf16_t*)(ws + WS_XB); float* ssx = (float*)(ws + WS_SSX);
      for (int r = gw; r < T; r += ngw) {
          const f32x4* xr = (const f32x4*)(p.x + (size_t)r * DM) + lane;
#pragma unroll
          for (int j = 0; j < 4; ++j) { const f32x4 v = xr[64 * j]; store4bf(XB + (size_t)r * DM + 256 * j + 4 * lane, v);
              float s = (v[0] * v[0] + v[1] * v[1]) + (v[2] * v[2] + v[3] * v[3]); s += __shfl_xor(s, 1); s += __shfl_xor(s, 2); s += __shfl_xor(s, 4);
              if ((lane & 7) == 0) ssx[(size_t)r * 32 + 8 * j + (lane >> 3)] = s; } } }
}

template <class Epi>
__device__ __forceinline__ void sgemm_tile(const bf16_t* A, int lda, const int* rowidx, const bf16_t* Bt, int ldb, int K, int row0, int col0, const Epi& E, unsigned char* smem) {
    const int tid = threadIdx.x, lane = tid & 63, wid = tid >> 6, wm = wid >> 2, wn = wid & 3, fr = lane & 15, fq = lane >> 4;
    bf16_t* As = (bf16_t*)smem; bf16_t* Bs = As + 128 * 40;
    const int lr = tid >> 2, lp = tid & 3;
    const int arow = rowidx ? rowidx[row0 + lr] : (row0 + lr);
    const bf16_t* ag = A + (size_t)arow * lda + lp * 8; const bf16_t* bg = Bt + (size_t)(col0 + lr) * ldb + lp * 8;
    f32x4 acc[4][2];
#pragma unroll
    for (int i = 0; i < 4; ++i) { acc[i][0] = (f32x4){0.f, 0.f, 0.f, 0.f}; acc[i][1] = (f32x4){0.f, 0.f, 0.f, 0.f}; }
    u32x4 ra = *(const u32x4*)ag, rb = *(const u32x4*)bg;
    const int nk = K / 32;
    for (int kt = 0; kt < nk; ++kt) {
        *(u32x4*)(As + lr * 40 + lp * 8) = ra; *(u32x4*)(Bs + lr * 40 + lp * 8) = rb;
        __syncthreads();
        if (kt + 1 < nk) { ra = *(const u32x4*)(ag + (kt + 1) * 32); rb = *(const u32x4*)(bg + (kt + 1) * 32); }
        bf16x8 af[4], bfr[2];
#pragma unroll
        for (int i = 0; i < 4; ++i) af[i] = *(const bf16x8*)(As + (wm * 64 + i * 16 + fr) * 40 + fq * 8);
#pragma unroll
        for (int j = 0; j < 2; ++j) bfr[j] = *(const bf16x8*)(Bs + (wn * 32 + j * 16 + fr) * 40 + fq * 8);
#pragma unroll
        for (int i = 0; i < 4; ++i)
#pragma unroll
            for (int j = 0; j < 2; ++j) acc[i][j] = __builtin_amdgcn_mfma_f32_16x16x32_bf16(bfr[j], af[i], acc[i][j], 0, 0, 0);
        __syncthreads();
    }
#pragma unroll
    for (int i = 0; i < 4; ++i) {
        const int row = row0 + wm * 64 + i * 16 + fr, col = col0 + wn * 32 + 4 * fq;
        float s = E(row, col, acc[i][0], acc[i][1]);
        s += __shfl_xor(s, 16); s += __shfl_xor(s, 32);
        if (fq == 0) E.stat(row, col, s);
    }
}

struct EpiIn {
    const float* ssx; bf16_t *XL, *GY, *CQ, *CKV, *KR; float *SSQ, *SSKV; const float* tab;
    __device__ __forceinline__ float operator()(int row, int col, f32x4 v0, f32x4 v1) const {
        if (col >= INC) return 0.f;
        const float rs = row_rs(ssx, row, 32, 1.0f / DM); v0 *= rs; v1 *= rs;
        if (col < 512) { store4bf(XL + (size_t)row * 512 + col, v0); store4bf(XL + (size_t)row * 512 + col + 16, v1); return 0.f; }
        if (col < 1024) { const int c = col - 512; f32x4 g0, g1;
#pragma unroll
            for (int e = 0; e < 4; ++e) { g0[e] = gelu_tanh(v0[e]); g1[e] = gelu_tanh(v1[e]); }
            store4bf(GY + (size_t)row * 512 + c, g0); store4bf(GY + (size_t)row * 512 + c + 16, g1); return 0.f; }
        const float ss = ((v0[0] * v0[0] + v0[1] * v0[1]) + (v0[2] * v0[2] + v0[3] * v0[3])) + ((v1[0] * v1[0] + v1[1] * v1[1]) + (v1[2] * v1[2] + v1[3] * v1[3]));
        if (col < 1280) { const int c = col - 1024; store4bf(CQ + (size_t)row * 256 + c, v0); store4bf(CQ + (size_t)row * 256 + c + 16, v1); return ss; }
        if (col < 1408) { const int c = col - 1280; store4bf(CKV + (size_t)row * 128 + c, v0); store4bf(CKV + (size_t)row * 128 + c + 16, v1); return ss; }
        { const int i0 = col - 1408; f32x4 o1, o2;
#pragma unroll
          for (int e = 0; e < 4; ++e) { const float c = tab[(size_t)row * 32 + 2 * (i0 + e)], s = tab[(size_t)row * 32 + 2 * (i0 + e) + 1]; o1[e] = v0[e] * c - v1[e] * s; o2[e] = v1[e] * c + v0[e] * s; }
          store4bf(KR + (size_t)row * 32 + i0, o1); store4bf(KR + (size_t)row * 32 + 16 + i0, o2); return 0.f; }
    }
    __device__ __forceinline__ void stat(int row, int col, float s) const {
        if (col >= 1024 && col < 1280) SSQ[(size_t)row * 8 + ((col - 1024) >> 5)] = s;
        else if (col >= 1280 && col < 1408) SSKV[(size_t)row * 4 + ((col - 1280) >> 5)] = s;
    }
};
struct EpiQ {
    const float* ssq; bf16_t* QF; const float* tab;
    __device__ __forceinline__ float operator()(int row, int col, f32x4 v0, f32x4 v1) const {
        const float rs = row_rs(ssq, row, 8, 1.0f / QLORA) * QSCALE; v0 *= rs; v1 *= rs;
        const int j = col % DQK;
        if (j < 64) { store4bf(QF + (size_t)row * QW + col, v0); store4bf(QF + (size_t)row * QW + col + 16, v1); }
        else { const int i0 = j - 64; f32x4 o1, o2;
#pragma unroll
            for (int e = 0; e < 4; ++e) { const float c = tab[(size_t)row * 32 + 2 * (i0 + e)], s = tab[(size_t)row * 32 + 2 * (i0 + e) + 1]; o1[e] = v0[e] * c - v1[e] * s; o2[e] = v1[e] * c + v0[e] * s; }
            store4bf(QF + (size_t)row * QW + col, o1); store4bf(QF + (size_t)row * QW + col + 16, o2); }
        return 0.f;
    }
    __device__ __forceinline__ void stat(int, int, float) const {}
};
struct EpiKV {
    const float* sskv; bf16_t *KF, *VT; const bf16_t* KR;
    __device__ __forceinline__ float operator()(int row, int col, f32x4 v0, f32x4 v1) const {
        const float rs = row_rs(sskv, row, 4, 1.0f / KVLORA); v0 *= rs; v1 *= rs;
        const int h = col >> 7, j = col & 127;
        if (j < 64) { bf16_t* kf = KF + (size_t)row * QW + h * DQK; store4bf(kf + j, v0); store4bf(kf + j + 16, v1);
            if (j < 32) { *(u32x2*)(kf + 64 + j) = *(const u32x2*)(KR + (size_t)row * 32 + j); *(u32x2*)(kf + 80 + j) = *(const u32x2*)(KR + (size_t)row * 32 + 16 + j); } }
        else { const int d = j - 64, b = row / SEQ, s = row % SEQ; bf16_t* vt = VT + ((size_t)(b * NH + h) * VH + d) * SEQ + s;
#pragma unroll
            for (int e = 0; e < 4; ++e) { vt[(size_t)e * SEQ] = (bf16_t)f2bf(v0[e]); vt[(size_t)(e + 16) * SEQ] = (bf16_t)f2bf(v1[e]); } }
        return 0.f;
    }
    __device__ __forceinline__ void stat(int, int, float) const {}
};
struct EpiRes {
    const float* xin; float* xout; bf16_t* XB; float* SSX;
    __device__ __forceinline__ float operator()(int row, int col, f32x4 v0, f32x4 v1) const {
        const size_t o = (size_t)row * DM + col;
        const f32x4 a = *(const f32x4*)(xin + o) + v0, b = *(const f32x4*)(xin + o + 16) + v1;
        *(f32x4*)(xout + o) = a; *(f32x4*)(xout + o + 16) = b; store4bf(XB + o, a); store4bf(XB + o + 16, b);
        return ((a[0] * a[0] + a[1] * a[1]) + (a[2] * a[2] + a[3] * a[3])) + ((b[0] * b[0] + b[1] * b[1]) + (b[2] * b[2] + b[3] * b[3]));
    }
    __device__ __forceinline__ void stat(int row, int col, float s) const { SSX[(size_t)row * 32 + (col >> 5)] = s; }
};
struct EpiGU {
    const float* ssx; const int* rowtok; bf16_t* ACT; int ldact; int colsub;
    __device__ __forceinline__ float operator()(int row, int col, f32x4 v0, f32x4 v1) const {
        const int tok = rowtok ? rowtok[row] : row; const float rs = row_rs(ssx, tok, 32, 1.0f / DM);
        f32x4 o;
#pragma unroll
        for (int e = 0; e < 4; ++e) { const float g = v0[e] * rs, u = v1[e] * rs; o[e] = g / (1.f + __expf(-g)) * u; }
        const int c = col - colsub; store4bf(ACT + (size_t)row * ldact + (c >> 5) * 16 + (c & 31), o);
        return 0.f;
    }
    __device__ __forceinline__ void stat(int, int, float) const {}
};
struct EpiED {
    const float* roww; const int* rowslot; bf16_t* Y;
    __device__ __forceinline__ float operator()(int row, int col, f32x4 v0, f32x4 v1) const {
        const int slot = rowslot[row]; if (slot < 0) return 0.f; const float w = roww[row];
        store4bf(Y + (size_t)slot * DM + col, v0 * w); store4bf(Y + (size_t)slot * DM + col + 16, v1 * w); return 0.f;
    }
    __device__ __forceinline__ void stat(int, int, float) const {}
};

template <class Epi>
__device__ __forceinline__ void sgemm_phase(const bf16_t* A, int lda, const bf16_t* Bt, int ldb, int M, int N, int K, const Epi& E, int bid, int nb, unsigned char* smem) {
    const int nM = M / 128, nN = N / 128;
    for (int u = bid; u < nM * nN; u += nb) { const int pm = u / nN, pn = u % nN; sgemm_tile(A, lda, nullptr, Bt, ldb, K, pm * 128, pn * 128, E, smem); }
}

__device__ __forceinline__ void expert_offsets(const int* cnt, int (&off)[NE + 1]) {
    int o = 0;
#pragma unroll
    for (int e = 0; e < NE; ++e) { off[e] = o; o += (cnt[e] + 255) & ~255; }
    off[NE] = o;
}

template <bool FIN>
__device__ __forceinline__ void lru_phase(const P& p, int l, int bid, int nb, unsigned char* smem) {
    const int c = threadIdx.x, blk = c >> 6, d = c & 63;
    unsigned char* ws = p.ws;
    const bf16_t* XL = (const bf16_t*)(ws + WS_XL); const bf16_t* GY = (const bf16_t*)(ws + WS_GY); bf16_t* MIX = (bf16_t*)(ws + WS_MIX); float* SUM = (float*)(ws + WS_SUM);
    float* xcs = (float*)smem;
    float wa[64], wx[64];
    const float* wap = p.lru_wa + ((size_t)(l * 8 + blk) * 64) * 64 + d; const float* wxp = p.lru_wx + ((size_t)(l * 8 + blk) * 64) * 64 + d;
#pragma unroll
    for (int k = 0; k < 64; ++k) { wa[k] = wap[k * 64]; wx[k] = wxp[k * 64]; }
    const float ba = p.lru_ba[l * LRU_W + c], bx = p.lru_bx[l * LRU_W + c];
    const float lam = p.lru_lambda[l * LRU_W + c]; const float sp8 = -8.0f * log1pf(expf(-lam));
    const float cw0 = p.conv_w[(l * 4 + 0) * LRU_W + c], cw1 = p.conv_w[(l * 4 + 1) * LRU_W + c], cw2 = p.conv_w[(l * 4 + 2) * LRU_W + c], cw3 = p.conv_w[(l * 4 + 3) * LRU_W + c], cb = p.conv_b[l * LRU_W + c];
    for (int ch = bid; ch < T / 64; ch += nb) {
        const int t0 = ch * 64, s0 = t0 % SEQ;
        float h = 0.f, Aacc = 1.f;
        if (FIN) { const int cfirst = (t0 / SEQ) * (SEQ / 64); for (int cc = cfirst; cc < ch; ++cc) { const float a_ = SUM[(size_t)cc * 1024 + c], h_ = SUM[(size_t)cc * 1024 + 512 + c]; h = a_ * h + h_; } }
        float x0 = 0.f, x1 = 0.f, x2 = 0.f;
        if (s0 > 0) { x0 = bf2f(XL[(size_t)(t0 - 3) * 512 + c]); x1 = bf2f(XL[(size_t)(t0 - 2) * 512 + c]); x2 = bf2f(XL[(size_t)(t0 - 1) * 512 + c]); }
        for (int sub = 0; sub < 4; ++sub) {
            float xc[16];
#pragma unroll
            for (int tt = 0; tt < 16; ++tt) { const float x3 = bf2f(XL[(size_t)(t0 + sub * 16 + tt) * 512 + c]); xc[tt] = cb + cw0 * x0 + cw1 * x1 + cw2 * x2 + cw3 * x3; x0 = x1; x1 = x2; x2 = x3; xcs[tt * 512 + c] = xc[tt]; }
            __syncthreads();
#pragma unroll 1
            for (int tt = 0; tt < 16; ++tt) {
                float r = ba, ig = bx; const f32x4* xr = (const f32x4*)(xcs + tt * 512 + blk * 64);
#pragma unroll
                for (int k4 = 0; k4 < 16; ++k4) { const f32x4 xv = xr[k4];
#pragma unroll
                    for (int e = 0; e < 4; ++e) { r += xv[e] * wa[4 * k4 + e]; ig += xv[e] * wx[4 * k4 + e]; } }
                r = sigmoidf_(r); ig = sigmoidf_(ig);
                const float la = sp8 * r, a = expf(la); float mult = sqrtf(-expm1f(2.0f * la));
                const int t = t0 + sub * 16 + tt; if ((t % SEQ) == 0) mult = 1.0f;
                const float xct = xcs[tt * 512 + c]; const float u = mult * (ig * xct);
                h = a * h + u; Aacc *= a;
                if (FIN) { const float g = bf2f(GY[(size_t)t * 512 + c]); MIX[(size_t)t * DM + c] = (bf16_t)f2bf(h * g); }
            }
            __syncthreads();
        }
        if (!FIN) { SUM[(size_t)ch * 1024 + c] = Aacc; SUM[(size_t)ch * 1024 + 512 + c] = h; }
    }
}

__device__ __forceinline__ int pi32(int r) { return (r & 0x13) | ((r & 4) << 1) | ((r & 8) >> 1); }
__device__ void attn_phase_simple(const P& p, int bid, int nb) {
    const int tid = threadIdx.x, lane = tid & 63, wid = tid >> 6, r32 = lane & 31, hi = lane >> 5;
    unsigned char* ws = p.ws;
    const bf16_t* QF = (const bf16_t*)(ws + WS_QF); const bf16_t* KF = (const bf16_t*)(ws + WS_KF); const bf16_t* VT = (const bf16_t*)(ws + WS_VT); bf16_t* MIX = (bf16_t*)(ws + WS_MIX);
    const int ntask = BATCH * NH * (SEQ / 32);
    for (int task = bid * NWAVE + wid; task < ntask; task += nb * NWAVE) {
        const int qb = (SEQ / 32 - 1) - task % (SEQ / 32), bh = task / (SEQ / 32), b = bh / NH, h = bh % NH;
        const int q0 = qb * 32; const size_t rowbase = (size_t)b * SEQ;
        bf16x8 qf[6];
#pragma unroll
        for (int s = 0; s < 6; ++s) qf[s] = *(const bf16x8*)(QF + (rowbase + q0 + r32) * QW + h * DQK + 16 * s + 8 * hi);
        f32x16 o0 = {}, o1 = {}; float m = -INFINITY, lsum = 0.f;
        const bf16_t* kbase = KF + rowbase * QW + h * DQK + 8 * hi; const bf16_t* vbase = VT + ((size_t)(b * NH + h) * VH + r32) * SEQ + 8 * hi;
        const int pr = pi32(r32);
        for (int kv0 = 0; kv0 <= q0; kv0 += 32) {
            f32x16 st = {};
            const bf16_t* kp = kbase + (size_t)(kv0 + pr) * QW;
#pragma unroll
            for (int s = 0; s < 6; ++s) { const bf16x8 kf = *(const bf16x8*)(kp + 16 * s); st = __builtin_amdgcn_mfma_f32_32x32x16_bf16(kf, qf[s], st, 0, 0, 0); }
            if (kv0 == q0) {
#pragma unroll
                for (int reg = 0; reg < 16; ++reg) { const int kvl = pi32((reg & 3) + 8 * (reg >> 2) + 4 * hi); if (kvl > r32) st[reg] = -INFINITY; }
            }
            float mx = st[0];
#pragma unroll
            for (int reg = 1; reg < 16; ++reg) mx = fmaxf(mx, st[reg]);
            mx = fmaxf(mx, __shfl_xor(mx, 32));
            const float mn = fmaxf(m, mx), alpha = exp2f(m - mn); m = mn;
            float ps = 0.f;
#pragma unroll
            for (int reg = 0; reg < 16; ++reg) { st[reg] = exp2f(st[reg] - mn); ps += st[reg]; }
            ps += __shfl_xor(ps, 32); lsum = lsum * alpha + ps;
#pragma unroll
            for (int reg = 0; reg < 16; ++reg) { o0[reg] *= alpha; o1[reg] *= alpha; }
            u32x4 pw0, pw1;
            pw0.x = pk2(st[0], st[1]); pw0.y = pk2(st[2], st[3]); pw0.z = pk2(st[4], st[5]); pw0.w = pk2(st[6], st[7]);
            pw1.x = pk2(st[8], st[9]); pw1.y = pk2(st[10], st[11]); pw1.z = pk2(st[12], st[13]); pw1.w = pk2(st[14], st[15]);
            const bf16x8 pb0 = __builtin_bit_cast(bf16x8, pw0), pb1 = __builtin_bit_cast(bf16x8, pw1);
            const bf16_t* vp = vbase + kv0;
            const bf16x8 va00 = *(const bf16x8*)(vp), va01 = *(const bf16x8*)(vp + 16), va10 = *(const bf16x8*)(vp + (size_t)32 * SEQ), va11 = *(const bf16x8*)(vp + (size_t)32 * SEQ + 16);
            o0 = __builtin_amdgcn_mfma_f32_32x32x16_bf16(va00, pb0, o0, 0, 0, 0); o0 = __builtin_amdgcn_mfma_f32_32x32x16_bf16(va01, pb1, o0, 0, 0, 0);
            o1 = __builtin_amdgcn_mfma_f32_32x32x16_bf16(va10, pb0, o1, 0, 0, 0); o1 = __builtin_amdgcn_mfma_f32_32x32x16_bf16(va11, pb1, o1, 0, 0, 0);
        }
        const float il = 1.0f / lsum; bf16_t* op = MIX + (rowbase + q0 + r32) * DM + 512 + h * VH;
#pragma unroll
        for (int g = 0; g < 4; ++g) { const int dd = 8 * g + 4 * hi;
            store4bf(op + dd, (f32x4){o0[4 * g] * il, o0[4 * g + 1] * il, o0[4 * g + 2] * il, o0[4 * g + 3] * il});
            store4bf(op + 32 + dd, (f32x4){o1[4 * g] * il, o1[4 * g + 1] * il, o1[4 * g + 2] * il, o1[4 * g + 3] * il}); }
    }
}

__device__ void router_phase(const P& p, int bid, int nb, unsigned char* smem) {
    const int tid = threadIdx.x, lane = tid & 63, wid = tid >> 6;
    unsigned char* ws = p.ws; const float* X = p.out; int* cnt = (int*)(ws + WS_CTL);
    int* TOPE = (int*)(ws + WS_TOPE); float* TOPW = (float*)(ws + WS_TOPW); int* RANK = (int*)(ws + WS_RANK);
    int* se = (int*)smem;
    const float* g = p.norm_ffn + DM; const float* rw = p.router_w;
    for (int grp = bid; grp < T / 64; grp += nb) {
        for (int i = 0; i < 8; ++i) {
            const int t = grp * 64 + wid * 8 + i; const float* xr = X + (size_t)t * DM;
            float acc[NE]; float ss = 0.f;
#pragma unroll
            for (int e = 0; e < NE; ++e) acc[e] = 0.f;
#pragma unroll
            for (int j = 0; j < 4; ++j) { const f32x4 xv = *(const f32x4*)(xr + 256 * j + 4 * lane); const f32x4 gv = *(const f32x4*)(g + 256 * j + 4 * lane);
#pragma unroll
                for (int q = 0; q < 4; ++q) { const float xs = xv[q]; ss += xs * xs; const float xg = xs * gv[q]; const float* w = rw + (size_t)(256 * j + 4 * lane + q) * NE; const f32x4 w0 = *(const f32x4*)w, w1 = *(const f32x4*)(w + 4);
                    acc[0] += xg * w0[0]; acc[1] += xg * w0[1]; acc[2] += xg * w0[2]; acc[3] += xg * w0[3]; acc[4] += xg * w1[0]; acc[5] += xg * w1[1]; acc[6] += xg * w1[2]; acc[7] += xg * w1[3]; } }
            ss = wave_sum(ss);
#pragma unroll
            for (int e = 0; e < NE; ++e) acc[e] = wave_sum(acc[e]);
            const float rs = rsqrtf(ss * (1.0f / DM) + EPS);
            int e1 = 0; float l1 = acc[0];
#pragma unroll
            for (int e = 1; e < NE; ++e) if (acc[e] > l1) { l1 = acc[e]; e1 = e; }
            int e2 = -1; float l2 = -INFINITY;
#pragma unroll
            for (int e = 0; e < NE; ++e) if (e != e1 && acc[e] > l2) { l2 = acc[e]; e2 = e; }
            const float w2 = 1.f / (1.f + expf((l1 - l2) * rs)), w1 = 1.f - w2;
            if (lane == 0) { TOPE[2 * t] = e1; TOPE[2 * t + 1] = e2; TOPW[2 * t] = w1; TOPW[2 * t + 1] = w2; se[2 * (wid * 8 + i)] = e1; se[2 * (wid * 8 + i) + 1] = e2; }
        }
        __syncthreads();
        if (wid == 0) {
            const int t = grp * 64 + lane, e1 = se[2 * lane], e2 = se[2 * lane + 1]; int r1 = 0, r2 = 0;
            for (int e = 0; e < NE; ++e) {
                const unsigned long long m1 = __ballot(e1 == e), m2 = __ballot(e2 == e);
                const int c1 = __popcll(m1), c2 = __popcll(m2);
                int base = 0; if (lane == 0 && (c1 + c2) > 0) base = atomicAdd(cnt + e, c1 + c2);
                base = __shfl(base, 0);
                const unsigned long long below = (lane == 0) ? 0ull : (~0ull >> (64 - lane));
                if (e1 == e) r1 = base + __popcll(m1 & below);
                if (e2 == e) r2 = base + c1 + __popcll(m2 & below);
            }
            RANK[2 * t] = r1; RANK[2 * t + 1] = r2;
        }
        __syncthreads();
    }
}
__device__ void gc_phase(const P& p, int bid, int nb) {
    unsigned char* ws = p.ws; const int* cnt = (const int*)(ws + WS_CTL); int off[NE + 1]; expert_offsets(cnt, off);
    const int* TOPE = (const int*)(ws + WS_TOPE); const float* TOPW = (const float*)(ws + WS_TOPW); const int* RANK = (const int*)(ws + WS_RANK);
    int* rt = (int*)(ws + WS_ROWTOK); float* rw = (float*)(ws + WS_ROWW); int* rs = (int*)(ws + WS_ROWSLOT);
    for (int i = bid * NTHR + threadIdx.x; i < 2 * T; i += nb * NTHR) {
        const int e = TOPE[i]; int o = 0;
#pragma unroll
        for (int q = 0; q < NE; ++q) if (q == e) o = off[q];
        const int pos = o + RANK[i]; rt[pos] = i >> 1; rw[pos] = TOPW[i]; rs[pos] = i;
    }
}
__device__ void egu_phase(const P& p, int bid, int nb, unsigned char* smem) {
    unsigned char* ws = p.ws; const int* cnt = (const int*)(ws + WS_CTL); int off[NE + 1]; expert_offsets(cnt, off);
    const int nM = off[NE] / 128, nN = (2 * DFE) / 128;
    for (int u = bid; u < nM * nN; u += nb) {
        const int pm = u / nN, pn = u % nN, row0 = pm * 128; int e = 0;
#pragma unroll
        for (int q = 1; q < NE; ++q) if (row0 >= off[q]) e = q;
        EpiGU E{(const float*)(ws + WS_SSX), (const int*)(ws + WS_ROWTOK), (bf16_t*)(ws + WS_ACT), DFE, 0};
        sgemm_tile((const bf16_t*)(ws + WS_XB), DM, (const int*)(ws + WS_ROWTOK), (const bf16_t*)(ws + WS_EGU) + (size_t)e * 2 * DFE * DM, DM, DM, row0, pn * 128, E, smem);
    }
}
__device__ void ed_phase(const P& p, int bid, int nb, unsigned char* smem) {
    unsigned char* ws = p.ws; const int* cnt = (const int*)(ws + WS_CTL); int off[NE + 1]; expert_offsets(cnt, off);
    const int nM = off[NE] / 128, nN = DM / 128;
    for (int u = bid; u < nM * nN; u += nb) {
        const int pm = u / nN, pn = u % nN, row0 = pm * 128; int e = 0;
#pragma unroll
        for (int q = 1; q < NE; ++q) if (row0 >= off[q]) e = q;
        EpiED E{(const float*)(ws + WS_ROWW), (const int*)(ws + WS_ROWSLOT), (bf16_t*)(ws + WS_Y)};
        sgemm_tile((const bf16_t*)(ws + WS_ACT), DFE, nullptr, (const bf16_t*)(ws + WS_ED) + (size_t)e * DM * DFE, DFE, DFE, row0, pn * 128, E, smem);
    }
}
__device__ void final_phase(const P& p, int bid, int nb) {
    const int lane = threadIdx.x & 63, wid = threadIdx.x >> 6; const bf16_t* Y = (const bf16_t*)(p.ws + WS_Y);
    for (int t = bid * NWAVE + wid; t < T; t += nb * NWAVE) {
        float* xr = p.out + (size_t)t * DM; f32x4 v[4]; float ss = 0.f;
#pragma unroll
        for (int j = 0; j < 4; ++j) { v[j] = *(const f32x4*)(xr + 256 * j + 4 * lane);
            const u32x2 a = *(const u32x2*)(Y + (size_t)(2 * t) * DM + 256 * j + 4 * lane), b = *(const u32x2*)(Y + (size_t)(2 * t + 1) * DM + 256 * j + 4 * lane);
            v[j][0] += bf2f(a.x & 0xffff) + bf2f(b.x & 0xffff); v[j][1] += bf2f(a.x >> 16) + bf2f(b.x >> 16); v[j][2] += bf2f(a.y & 0xffff) + bf2f(b.y & 0xffff); v[j][3] += bf2f(a.y >> 16) + bf2f(b.y >> 16);
            ss += (v[j][0] * v[j][0] + v[j][1] * v[j][1]) + (v[j][2] * v[j][2] + v[j][3] * v[j][3]); }
        ss = wave_sum(ss); const float rs = rsqrtf(ss * (1.0f / DM) + EPS);
#pragma unroll
        for (int j = 0; j < 4; ++j) { const f32x4 g = *(const f32x4*)(p.norm_final + 256 * j + 4 * lane); *(f32x4*)(xr + 256 * j + 4 * lane) = v[j] * rs * g; }
    }
}

enum { K_P0, K_GIN, K_LRUSUM, K_GQ, K_GKV, K_ATTN, K_LRUFIN, K_GOUT, K_FUP, K_FDOWN, K_ROUTER, K_GC, K_EGU, K_ED, K_FINAL };
template <int KIND>
__device__ __forceinline__ void run_kind(const P& p, int l, int bid, int nb, unsigned char* smem) {
    unsigned char* ws = p.ws;
    const float* xin = (l == 0) ? p.x : p.out;
    if constexpr (KIND == K_P0) phase_p0(p, bid, nb, smem);
    else if constexpr (KIND == K_GIN) {
        EpiIn E{(const float*)(ws + WS_SSX), (bf16_t*)(ws + WS_XL), (bf16_t*)(ws + WS_GY), (bf16_t*)(ws + WS_CQ), (bf16_t*)(ws + WS_CKV), (bf16_t*)(ws + WS_KR), (float*)(ws + WS_SSQ), (float*)(ws + WS_SSKV), (const float*)(ws + WS_TAB)};
        sgemm_phase((const bf16_t*)(ws + WS_XB), DM, (const bf16_t*)(ws + WS_WIN) + (size_t)l * INCP * DM, DM, T, INCP, DM, E, bid, nb, smem);
    } else if constexpr (KIND == K_LRUSUM) lru_phase<false>(p, l, bid, nb, smem);
    else if constexpr (KIND == K_GQ) {
        EpiQ EQ{(const float*)(ws + WS_SSQ), (bf16_t*)(ws + WS_QF), (const float*)(ws + WS_TAB)};
        sgemm_phase((const bf16_t*)(ws + WS_CQ), QLORA, (const bf16_t*)(ws + WS_WUQ) + (size_t)l * QW * QLORA, QLORA, T, QW, QLORA, EQ, bid, nb, smem);
    } else if constexpr (KIND == K_GKV) {
        EpiKV EK{(const float*)(ws + WS_SSKV), (bf16_t*)(ws + WS_KF), (bf16_t*)(ws + WS_VT), (const bf16_t*)(ws + WS_KR)};
        sgemm_phase((const bf16_t*)(ws + WS_CKV), KVLORA, (const bf16_t*)(ws + WS_WUKV) + (size_t)l * KVW * KVLORA, KVLORA, T, KVW, KVLORA, EK, bid, nb, smem);
    } else if constexpr (KIND == K_ATTN) attn_phase_simple(p, bid, nb);
    else if constexpr (KIND == K_LRUFIN) lru_phase<true>(p, l, bid, nb, smem);
    else if constexpr (KIND == K_GOUT) {
        EpiRes E{xin, p.out, (bf16_t*)(ws + WS_XB), (float*)(ws + WS_SSX)};
        sgemm_phase((const bf16_t*)(ws + WS_MIX), DM, (const bf16_t*)(ws + WS_WOUT) + (size_t)l * DM * DM, DM, T, DM, DM, E, bid, nb, smem);
    } else if constexpr (KIND == K_FUP) {
        EpiGU E{(const float*)(ws + WS_SSX), nullptr, (bf16_t*)(ws + WS_ACT), DFF, 0};
        sgemm_phase((const bf16_t*)(ws + WS_XB), DM, (const bf16_t*)(ws + WS_WGU), DM, T, 2 * DFF, DM, E, bid, nb, smem);
    } else if constexpr (KIND == K_FDOWN) {
        EpiRes E{p.out, p.out, (bf16_t*)(ws + WS_XB), (float*)(ws + WS_SSX)};
        sgemm_phase((const bf16_t*)(ws + WS_ACT), DFF, (const bf16_t*)(ws + WS_WD), DFF, T, DM, DFF, E, bid, nb, smem);
    } else if constexpr (KIND == K_ROUTER) router_phase(p, bid, nb, smem);
    else if constexpr (KIND == K_GC) gc_phase(p, bid, nb);
    else if constexpr (KIND == K_EGU) egu_phase(p, bid, nb, smem);
    else if constexpr (KIND == K_ED) ed_phase(p, bid, nb, smem);
    else final_phase(p, bid, nb);
}

constexpr int LDS_BYTES = 8 * 64 * 33 * 4;
template <int KIND>
__global__ void __launch_bounds__(NTHR) k_phase(P p, int l) {
    extern __shared__ __attribute__((aligned(16))) unsigned char smem[];
    run_kind<KIND>(p, l, (int)blockIdx.x, (int)gridDim.x, smem);
}
template <int KIND> static void launch_kind(const P& p, int l, int grid, hipStream_t stream) {
    static bool attr = false;
    if (!attr) { (void)hipFuncSetAttribute((const void*)k_phase<KIND>, hipFuncAttributeMaxDynamicSharedMemorySize, LDS_BYTES); attr = true; }
    hipLaunchKernelGGL(k_phase<KIND>, dim3(grid), dim3(NTHR), LDS_BYTES, stream, p, l);
}

extern "C" void kernel_launch(void* const* d_in, const int* in_sizes, int n_in, void* d_out, int out_size, void* d_ws, size_t ws_size, hipStream_t stream) {
    if (n_in != 25 || out_size != T * DM || ws_size < WS_END) { fprintf(stderr, "kernel_launch: unexpected shapes (n_in %d, out %d, ws %zu)\n", n_in, out_size, ws_size); return; }
    P p{};
    p.x = (const float*)d_in[0]; p.positions = (const int*)d_in[1]; p.norm_mix = (const float*)d_in[2]; p.w_in = (const float*)d_in[3]; p.conv_w = (const float*)d_in[4]; p.conv_b = (const float*)d_in[5];
    p.lru_wa = (const float*)d_in[6]; p.lru_ba = (const float*)d_in[7]; p.lru_wx = (const float*)d_in[8]; p.lru_bx = (const float*)d_in[9]; p.lru_lambda = (const float*)d_in[10]; p.q_norm = (const float*)d_in[11];
    p.w_uq = (const float*)d_in[12]; p.kv_norm = (const float*)d_in[13]; p.w_ukv = (const float*)d_in[14]; p.w_out = (const float*)d_in[15]; p.norm_ffn = (const float*)d_in[16];
    p.dense_w_gate = (const float*)d_in[17]; p.dense_w_up = (const float*)d_in[18]; p.dense_w_down = (const float*)d_in[19]; p.router_w = (const float*)d_in[20];
    p.expert_w_gate = (const float*)d_in[21]; p.expert_w_up = (const float*)d_in[22]; p.expert_w_down = (const float*)d_in[23]; p.norm_final = (const float*)d_in[24];
    p.out = (float*)d_out; p.ws = (unsigned char*)d_ws;
    const int G = 1024;
    launch_kind<K_P0>(p, 0, G, stream);
    for (int l = 0; l < DEPTH; ++l) {
        launch_kind<K_GIN>(p, l, G, stream);
        launch_kind<K_LRUSUM>(p, l, 256, stream); launch_kind<K_GQ>(p, l, G, stream); launch_kind<K_GKV>(p, l, G, stream);
        launch_kind<K_ATTN>(p, l, G, stream); launch_kind<K_LRUFIN>(p, l, 256, stream);
        launch_kind<K_GOUT>(p, l, G, stream);
        if (l == 0) { launch_kind<K_FUP>(p, l, G, stream); launch_kind<K_FDOWN>(p, l, G, stream); }
        else { launch_kind<K_ROUTER>(p, l, 256, stream); launch_kind<K_GC>(p, l, 64, stream); launch_kind<K_EGU>(p, l, G, stream); launch_kind<K_ED>(p, l, G, stream); launch_kind<K_FINAL>(p, l, G, stream); }
    }
}
```

```cpp
#include <hip/hip_runtime.h>
#include <hip/hip_cooperative_groups.h>
#include <cstdint>
#include <cstdio>
namespace cg = cooperative_groups;
#ifndef MK_MODE
#define MK_MODE 1
#endif

#define LAS __attribute__((address_space(3)))
typedef unsigned short bf16_t;
typedef short bf16x8 __attribute__((ext_vector_type(8)));
typedef float f32x4 __attribute__((ext_vector_type(4)));
typedef float f32x16 __attribute__((ext_vector_type(16)));
typedef unsigned u32x4 __attribute__((ext_vector_type(4)));
typedef unsigned u32x2 __attribute__((ext_vector_type(2)));
typedef float f32x2_t __attribute__((ext_vector_type(2)));

constexpr int BATCH = 4, SEQ = 4096, T = BATCH * SEQ, DM = 1024, DEPTH = 2;
constexpr int LRU_W = 512, NH = 8, QKN = 64, QKR = 32, VH = 64, QLORA = 256, KVLORA = 128;
constexpr int INC = 1440, INCP = 1536, DQK = QKN + QKR  , QW = NH * DQK  , KVW = NH * (QKN + VH)  ;
constexpr int DFF = 2816, NE = 8, DFE = 1792;
constexpr float EPS = 1e-6f;
constexpr int NTHR = 512, NWAVE = 8;
constexpr int ROWS_MAX = 2 * T + NE * 256;
constexpr float QSCALE = 0.10206207261596577f * 1.4426950408889634f;

constexpr size_t MiB = 1u << 20;
constexpr size_t WS_CTL = 0;
constexpr size_t WS_TAB = 1 * MiB;
constexpr size_t WS_SSX = 3 * MiB;
constexpr size_t WS_SSQ = 5 * MiB;
constexpr size_t WS_SSKV = 5 * MiB + 512 * 1024;
constexpr size_t WS_SUM = 6 * MiB;
constexpr size_t WS_TOPE = 7 * MiB;
constexpr size_t WS_TOPW = WS_TOPE + 128 * 1024;
constexpr size_t WS_RANK = WS_TOPW + 128 * 1024;
constexpr size_t WS_ROWTOK = WS_RANK + 128 * 1024;
constexpr size_t WS_ROWW = WS_ROWTOK + 136 * 1024;
constexpr size_t WS_ROWSLOT = WS_ROWW + 136 * 1024;
constexpr size_t WS_RSTOK = WS_ROWSLOT + 136 * 1024;
constexpr size_t WS_ROWRS = WS_RSTOK + 64 * 1024;
constexpr size_t WS_LW = 5 * MiB + 768 * 1024;
constexpr size_t WS_WIN = 8 * MiB;
constexpr size_t WS_WUQ = 14 * MiB;
constexpr size_t WS_WUKV = 15 * MiB;
constexpr size_t WS_WOUT = 16 * MiB;
constexpr size_t WS_WGU = 20 * MiB;
constexpr size_t WS_WD = 31 * MiB;
constexpr size_t WS_XB = 37 * MiB;
constexpr size_t WS_EGU = 84 * MiB;
constexpr size_t WS_ED = 69 * MiB;
constexpr size_t WS_LAU = 116 * MiB;
constexpr size_t WS_Y = 84 * MiB;
constexpr size_t WS_XB8 = 216 * MiB;
constexpr size_t WS_ACT = 153 * MiB;
constexpr size_t WS_XL = 153 * MiB, WS_GY = 169 * MiB, WS_QF = 185 * MiB, WS_KF = 209 * MiB, WS_VT = 233 * MiB;
constexpr size_t WS_CQ = 249 * MiB  , WS_KR = 225 * MiB  , WS_MIX = 249 * MiB;
constexpr size_t WS_END = 281 * MiB;

constexpr int MISC_OFF = 163840 - 256;
constexpr int CW_BAR = 4096;
constexpr size_t CTL_ZERO_BYTES = 65536;
struct P {
    const float *x; const int* positions; const float *norm_mix, *w_in, *conv_w, *conv_b, *lru_wa, *lru_ba, *lru_wx, *lru_bx, *lru_lambda, *q_norm, *w_uq, *kv_norm, *w_ukv,
        *w_out, *norm_ffn, *dense_w_gate, *dense_w_up, *dense_w_down, *router_w, *expert_w_gate, *expert_w_up, *expert_w_down, *norm_final;
    float* out; unsigned char* ws;
};
typedef const __attribute__((address_space(4))) P* PP;

__device__ __forceinline__ int otid(int wv) { int t = (wv << 6) | (int)__builtin_amdgcn_mbcnt_hi(~0u, __builtin_amdgcn_mbcnt_lo(~0u, 0u)); asm volatile("" : "+v"(t)); return t; }
typedef __bf16 bf16x2_t __attribute__((ext_vector_type(2)));
__device__ __forceinline__ unsigned pk2(float lo, float hi) { f32x2_t v = {lo, hi}; bf16x2_t b = __builtin_convertvector(v, bf16x2_t); return __builtin_bit_cast(unsigned, b); }
__device__ __forceinline__ unsigned f2bf(float f) { return pk2(f, 0.f) & 0xffffu; }
__device__ __forceinline__ float bf2f(unsigned short b) { return __builtin_bit_cast(float, (unsigned)b << 16); }
constexpr float F8_WS = 256.f, F8_XS = 8.f, F8_AS = 16.f;
__device__ __forceinline__ unsigned pk4_fp8(float a, float b, float c, float d) {
    a = fminf(fmaxf(a, -448.f), 448.f); b = fminf(fmaxf(b, -448.f), 448.f); c = fminf(fmaxf(c, -448.f), 448.f); d = fminf(fmaxf(d, -448.f), 448.f);
    unsigned w = 0u; w = __builtin_amdgcn_cvt_pk_fp8_f32(a, b, w, false); w = __builtin_amdgcn_cvt_pk_fp8_f32(c, d, w, true); return w; }
__device__ __forceinline__ void store4bf(bf16_t* p, f32x4 v) { u32x2 w; w.x = pk2(v[0], v[1]); w.y = pk2(v[2], v[3]); *(u32x2*)p = w; }
__device__ __forceinline__ void store8bf_x(bf16_t* p, int col, f32x4 v0, f32x4 v1) {
    const auto rx = __builtin_amdgcn_permlane16_swap(pk2(v0[0], v0[1]), pk2(v1[0], v1[1]), false, false), ry = __builtin_amdgcn_permlane16_swap(pk2(v0[2], v0[3]), pk2(v1[2], v1[3]), false, false);
    *(u32x4*)((col & 4) ? p + 12 : p) = (u32x4){rx[0], ry[0], rx[1], ry[1]};
}
__device__ __forceinline__ void store4bf_x(bf16_t* p, int col, f32x4 v) {
    const unsigned ax = pk2(v[0], v[1]), ay = pk2(v[2], v[3]);
    const auto rx = __builtin_amdgcn_permlane16_swap(ax, ax, false, false), ry = __builtin_amdgcn_permlane16_swap(ay, ay, false, false);
    if (!(col & 4)) *(u32x4*)p = (u32x4){rx[0], ry[0], rx[1], ry[1]};
}
__device__ __forceinline__ float sigmoidf_(float x) { return __builtin_amdgcn_rcpf(1.f + __builtin_amdgcn_exp2f(-1.4426950408889634f * x)); }
__device__ __forceinline__ float gelu_tanh(float x) { const float u = 0.7978845608028654f * (x + 0.044715f * x * x * x); return x * sigmoidf_(2.0f * u); }
__device__ __forceinline__ float fq_sum(float s) {
    { const auto r = __builtin_amdgcn_permlane16_swap(__float_as_uint(s), __float_as_uint(s), false, false); s = __uint_as_float(r[0]) + __uint_as_float(r[1]); }
    { const auto r = __builtin_amdgcn_permlane32_swap(__float_as_uint(s), __float_as_uint(s), false, false); s = __uint_as_float(r[0]) + __uint_as_float(r[1]); }
    return s; }
__device__ __forceinline__ float shfl_xor_l(float v, int lane, int mask) { return __builtin_bit_cast(float, __builtin_amdgcn_ds_bpermute((lane ^ mask) << 2, __builtin_bit_cast(int, v))); }
__device__ __forceinline__ float wave_sum(float v, int lane) {
#pragma unroll
    for (int o = 1; o < 64; o <<= 1) v += shfl_xor_l(v, lane, o);
    return v;
}
__device__ __forceinline__ float row_rs(const float* ss, int row, int nslot, float inv_n) {
    float s = 0.f;
    for (int i = 0; i < nslot; i += 4) { const f32x4 v = *(const f32x4*)(ss + (size_t)row * nslot + i); s += (v[0] + v[1]) + (v[2] + v[3]); }
    return rsqrtf(s * inv_n + EPS);
}

constexpr int NMAT = 4 * DEPTH + 2 * 8 * DEPTH + 3 + 3 * NE;
struct MatDesc { const float* src; bf16_t* dst; const float* gain; int K, N, ldk, koff, mode, start, f8; };
__device__ __forceinline__ void get_mat(PP p, int m, MatDesc& d) {
    unsigned char* ws = p->ws; d.gain = nullptr; d.mode = 0; d.koff = 0; d.start = 0; d.f8 = 0;
    if (m < 4 * DEPTH) { const int l = m >> 2, w = m & 3;
        if (w == 0) { d.src = p->w_in + (size_t)l * DM * INC; d.K = DM; d.N = INC; d.dst = (bf16_t*)(ws + WS_WIN) + (size_t)l * INCP * DM; d.gain = p->norm_mix + l * DM; d.ldk = DM; }
        else if (w == 1) { d.src = p->w_uq + (size_t)l * QLORA * QW; d.K = QLORA; d.N = QW; d.dst = (bf16_t*)(ws + WS_WUQ) + (size_t)l * QW * QLORA; d.gain = p->q_norm + l * QLORA; d.ldk = QLORA; }
        else if (w == 2) { d.src = p->w_ukv + (size_t)l * KVLORA * KVW; d.K = KVLORA; d.N = KVW; d.dst = (bf16_t*)(ws + WS_WUKV) + (size_t)l * KVW * 256; d.gain = p->kv_norm + l * KVLORA; d.ldk = 256; d.koff = 128; }
        else { d.src = p->w_out + (size_t)l * DM * DM; d.K = DM; d.N = DM; d.dst = (bf16_t*)(ws + WS_WOUT) + (size_t)l * DM * DM; d.ldk = DM; }
        return; }
    m -= 4 * DEPTH;
    if (m < 2 * 8 * DEPTH) { const int q = m >> 1, w = m & 1; d.src = (w ? p->lru_wx : p->lru_wa) + (size_t)q * 4096; d.K = 64; d.N = 64; d.dst = (bf16_t*)(ws + WS_LW) + (size_t)(q * 2 + w) * 4096; d.ldk = 64; return; }
    m -= 2 * 8 * DEPTH;
    if (m < 3) {
        if (m == 0) { d.src = p->dense_w_gate; d.K = DM; d.N = DFF; d.dst = (bf16_t*)(ws + WS_WGU); d.gain = p->norm_ffn; d.ldk = DM; d.mode = 1; }
        else if (m == 1) { d.src = p->dense_w_up; d.K = DM; d.N = DFF; d.dst = (bf16_t*)(ws + WS_WGU); d.gain = p->norm_ffn; d.ldk = DM; d.mode = 2; }
        else { d.src = p->dense_w_down; d.K = DFF; d.N = DM; d.dst = (bf16_t*)(ws + WS_WD); d.ldk = DFF; }
        return; }
    m -= 3;
    { const int e = m / 3, w = m % 3;
      d.f8 = 1;
      if (w == 0) { d.src = p->expert_w_gate + (size_t)e * DM * DFE; d.K = DM; d.N = DFE; d.dst = (bf16_t*)(ws + WS_EGU + (size_t)e * 2 * DFE * DM); d.gain = p->norm_ffn + DM; d.ldk = DM; d.mode = 1; }
      else if (w == 1) { d.src = p->expert_w_up + (size_t)e * DM * DFE; d.K = DM; d.N = DFE; d.dst = (bf16_t*)(ws + WS_EGU + (size_t)e * 2 * DFE * DM); d.gain = p->norm_ffn + DM; d.ldk = DM; d.mode = 2; }
      else { d.src = p->expert_w_down + (size_t)e * DFE * DM; d.K = DFE; d.N = DM; d.dst = (bf16_t*)(ws + WS_ED + (size_t)e * DM * DFE); d.ldk = DFE; } }
}

__device__ void phase_p0(PP p, int wv, int bid, int nb, unsigned char* smem) {
    const int tid = otid(wv), lane = tid & 63, wid = tid >> 6;
    const int gw = bid * NWAVE + wid, ngw = nb * NWAVE;
    unsigned char* ws = p->ws;
    MatDesc* tabm = (MatDesc*)smem;
    if (tid < NMAT) { MatDesc d; get_mat(p, tid, d); const int ksh = d.f8 ? 2 : 1; d.start = (d.K >> (5 + ksh)) * ((d.N + (256 >> ksh) - 1) / (256 >> ksh)); tabm[tid] = d; }
    __syncthreads();
    if (tid == 0) { int acc = 0; for (int m = 0; m < NMAT; ++m) { const int n = tabm[m].start; tabm[m].start = acc; acc += n; } ((int*)(tabm + NMAT))[0] = acc; }
    __syncthreads();
    const int total = ((const int*)(tabm + NMAT))[0];
    for (int item = gw; item < total; item += ngw) {
        int lo = 0, hi = NMAT - 1;
        while (lo < hi) { const int mid = (lo + hi + 1) >> 1; if (tabm[mid].start <= item) lo = mid; else hi = mid - 1; }
        const MatDesc d = tabm[lo];
        const int ksh = d.f8 ? 2 : 1, nw = 256 >> ksh, local = item - d.start, nbn = (d.N + nw - 1) / nw, kb = local / nbn, nbk = local % nbn, k0 = (32 << ksh) * kb + 32 * (lane & ((1 << ksh) - 1)), n0 = nw * nbk + 4 * (lane >> ksh);
        if (n0 < d.N) {
            f32x4 v[32];
#pragma unroll
            for (int j = 0; j < 32; ++j) v[j] = __builtin_nontemporal_load((const f32x4*)(d.src + (size_t)(k0 + j) * d.N + n0));
            if (d.gain) {
#pragma unroll
                for (int j = 0; j < 32; ++j) v[j] *= d.gain[k0 + j];
            }
#pragma unroll
            for (int e = 0; e < 4; ++e) { const int n = n0 + e; const int drow = d.mode == 0 ? n : ((n >> 4) * 32 + (n & 15) + (d.mode == 2 ? 16 : 0));
                if (d.f8) { unsigned char* dp8 = (unsigned char*)d.dst + (size_t)drow * d.ldk + k0;
#pragma unroll
                    for (int q = 0; q < 2; ++q) { u32x4 o;
#pragma unroll
                        for (int r = 0; r < 4; ++r) o[r] = pk4_fp8(v[16 * q + 4 * r][e] * F8_WS, v[16 * q + 4 * r + 1][e] * F8_WS, v[16 * q + 4 * r + 2][e] * F8_WS, v[16 * q + 4 * r + 3][e] * F8_WS);
                        *(u32x4*)(dp8 + 16 * q) = o; } }
                else { bf16_t* dp = d.dst + (size_t)drow * d.ldk + d.koff + k0;
#pragma unroll
                for (int q = 0; q < 4; ++q) { u32x4 o; o.x = pk2(v[8 * q][e], v[8 * q + 1][e]); o.y = pk2(v[8 * q + 2][e], v[8 * q + 3][e]); o.z = pk2(v[8 * q + 4][e], v[8 * q + 5][e]); o.w = pk2(v[8 * q + 6][e], v[8 * q + 7][e]);
                    *(u32x4*)(dp + 8 * q) = o; } } }
        }
    }
    const int gt = bid * NTHR + tid, ngt = nb * NTHR;
    for (int l = 0; l < DEPTH; ++l) { u32x4* z = (u32x4*)((bf16_t*)(ws + WS_WIN) + ((size_t)l * INCP + INC) * DM); for (int i = gt; i < (INCP - INC) * DM / 8; i += ngt) z[i] = (u32x4){0u, 0u, 0u, 0u}; }
    for (int l = 0; l < DEPTH; ++l) { bf16_t* wk = (bf16_t*)(ws + WS_WUKV) + (size_t)l * KVW * 256; for (int i = gt; i < KVW * 16; i += ngt) *(u32x4*)(wk + (size_t)(i >> 4) * 256 + (i & 15) * 8) = (u32x4){0u, 0u, 0u, 0u}; }
    { float* tab = (float*)(ws + WS_TAB);
      for (int i = gt; i < T * 16; i += ngt) { const int t = i >> 4, f = i & 15; const float inv = 1.0f / powf(10000.0f, (float)f / 16.0f); const float ang = (float)p->positions[t] * inv;
          float s, c; sincosf(ang, &s, &c); tab[2 * i] = c; tab[2 * i + 1] = s; } }
    { int* cnt = (int*)(ws + WS_CTL); if (gt < 64) cnt[gt] = 0;
      int* rt = (int*)(ws + WS_ROWTOK); float* rw = (float*)(ws + WS_ROWW); int* rs = (int*)(ws + WS_ROWSLOT); float* rrs = (float*)(ws + WS_ROWRS);
      for (int i = gt; i < ROWS_MAX; i += ngt) { rt[i] = 0; rw[i] = 0.f; rs[i] = -1; rrs[i] = 0.f; } }
    { bf16_t* XB = (bf16_t*)(ws + WS_XB); float* ssx = (float*)(ws + WS_SSX);
      for (int r = 2 * gw; r < T; r += 2 * ngw) {
          const f32x4* xr = (const f32x4*)(p->x + (size_t)r * DM) + lane; f32x4 v[8];
#pragma unroll
          for (int j = 0; j < 8; ++j) v[j] = __builtin_nontemporal_load(xr + 64 * j);
#pragma unroll
          for (int j = 0; j < 8; ++j) { const int rr = r + (j >> 2), jj = j & 3; store4bf(XB + (size_t)rr * DM + 256 * jj + 4 * lane, v[j]);
              float s = (v[j][0] * v[j][0] + v[j][1] * v[j][1]) + (v[j][2] * v[j][2] + v[j][3] * v[j][3]); s += shfl_xor_l(s, lane, 1); s += shfl_xor_l(s, lane, 2); s += shfl_xor_l(s, lane, 4);
              if ((lane & 7) == 0) ssx[(size_t)rr * 32 + 8 * jj + (lane >> 3)] = s; } } }
}

namespace pg8 {
#define PG8_LAS __attribute__((address_space(3)))
constexpr int BM = 256, BK = 64, HALF = 128, HTB = HALF * BK * 2, STAGE_BYTES = 8 * HTB, NXCD = 8, WGM = 8;
__host__ __device__ __forceinline__ int lds_byte(int r, int c) { const int st = (r >> 4) * 2 + (c >> 5), rr = r & 15, cc = c & 31, ob = rr * 64 + cc * 2; return st * 1024 + (ob ^ (((ob >> 9) & 1) << 5)); }
__host__ __device__ __forceinline__ void stage_rc(int b, int& R, int& C) { const int st = b / 1024, sb = b % 1024, swz = sb ^ (((sb >> 9) & 1) << 5); R = (st >> 1) * 16 + swz / 64; C = (st & 1) * 32 + (swz % 64) / 2; }
typedef int v8i_t __attribute__((ext_vector_type(8))); typedef int v4i_t __attribute__((ext_vector_type(4)));
__device__ __forceinline__ v8i_t cat8(bf16x8 a, bf16x8 b) { const v4i_t x = __builtin_bit_cast(v4i_t, a), y = __builtin_bit_cast(v4i_t, b); return __builtin_shufflevector(x, y, 0, 1, 2, 3, 4, 5, 6, 7); }
struct Unit { int pm, pn, hf; };
struct Gemm { const bf16_t* A; const bf16_t* Bt; int lda, ldb, K; const int* rowidx; };
struct StaticOrder {
    int nM, nN, nwg, G, c, full, tail2;
    __device__ __forceinline__ void init(int nM_, int nN_, int G_, int c_) { nM = nM_; nN = nN_; nwg = nM * nN; G = G_; c = c_; full = (nwg / G) * G; const int R = nwg - full; tail2 = (R > 0 && 2 * R <= G) ? 2 * R : 0; }
    __device__ __forceinline__ bool next(int i, Unit& u) const {
        if (tail2 && c < tail2 && (c & 1)) { const int rt = full / G; if (i > rt) return false; i = (i == 0) ? rt : i - 1; }
        const long L = (long)i * G + c; int wgid; u.hf = -1;
        if (tail2 && L >= full) { const int t = (int)(L - full); if (t >= tail2) return false; wgid = full + (t >> 1); u.hf = t & 1; }
        else { if (L >= nwg) return false; wgid = (int)L; }
        { const int q = nwg / NXCD, r = nwg % NXCD, xcd = wgid % NXCD, off = wgid / NXCD; wgid = (xcd < r ? xcd * (q + 1) : r * (q + 1) + (xcd - r) * q) + off; }
        const int nig = WGM * nN, gid = wgid / nig, fm = gid * WGM, gsz = (nM - fm) < WGM ? (nM - fm) : WGM;
        u.pm = fm + ((wgid % nig) % gsz); u.pn = (wgid % nig) / gsz; return true;
    }
};
struct GroupedOrder {
    StaticOrder so; int o1, o2, o3, o4, o5, o6, o7;
    __device__ __forceinline__ bool next(int i, Unit& u) const {
        if (!so.next(i, u)) return false;
        const int r0 = u.pm * BM; const int e = (r0 >= o1) + (r0 >= o2) + (r0 >= o3) + (r0 >= o4) + (r0 >= o5) + (r0 >= o6) + (r0 >= o7);
        u.pn += e * so.nN; return true;
    }
};
template <class Epi, class Sched, bool ALIGN_EPI, bool GATHER, bool FP8 = false>
__device__ __forceinline__ void gemm_phase(int wv, PG8_LAS unsigned char* lds, const Gemm g, const Sched& S, const Epi& E) {
    const int tid = otid(wv), wid = __builtin_amdgcn_readfirstlane(tid >> 6), lane = tid & 63, wr = wid >> 2, wc = wid & 3, fr = lane & 15, fq = lane >> 4;
    const int K = g.K, nt = K / BK;
    int Rr[2]; unsigned cA2[2]; unsigned voffA[2][2], nvoffA[2][2], voffB[2];
#pragma unroll
    for (int i = 0; i < 2; ++i) { int R, C; stage_rc(tid * 16 + i * 8192, R, C); Rr[i] = R; cA2[i] = (unsigned)C * 2u;
        voffA[0][i] = (unsigned)(R * g.lda + C) * 2u; voffA[1][i] = (unsigned)((R + HALF) * g.lda + C) * 2u; voffB[i] = (unsigned)(R * g.ldb + C) * 2u;
        nvoffA[0][i] = voffA[0][i]; nvoffA[1][i] = voffA[1][i]; }
    const size_t kstep = (size_t)(BK * 2);
    const size_t hstepB = (size_t)HALF * g.ldb * 2, tstepB = 2 * hstepB, tstepA = (size_t)BM * g.lda * 2;
    const unsigned ldsw = (unsigned)wid * 1024u;
    const int aoff = lds_byte(wr * 64 + fr, fq * 8), boff = lds_byte(wc * 32 + fr, fq * 8);
#define PG8_SA(b, h) (((b) * 2 + (h)) * HTB)
#define PG8_SB(b, h) ((4 + (b) * 2 + (h)) * HTB)
#define PG8_STAGE(bufoff, gbase, voff) do { _Pragma("unroll") for (int _i = 0; _i < 2; ++_i) \
        __builtin_amdgcn_global_load_lds((const unsigned*)((const char*)(gbase) + (voff)[_i]), (PG8_LAS unsigned*)(lds + (bufoff) + ldsw + _i * 8192), 16, 0, 0); } while (0)
#define PG8_STAGE_SEL(bufoff, gbase, sel, vn, vc) do { _Pragma("unroll") for (int _i = 0; _i < 2; ++_i) \
        __builtin_amdgcn_global_load_lds((const unsigned*)((const char*)(gbase) + ((sel) ? (vn)[_i] : (vc)[_i])), (PG8_LAS unsigned*)(lds + (bufoff) + ldsw + _i * 8192), 16, 0, 0); } while (0)
#define PG8_LDA(dst, b, h) do { _Pragma("unroll") for (int m = 0; m < 4; ++m) { \
        if constexpr (FP8) dst##8[m] = cat8(*(const PG8_LAS bf16x8*)(lds + PG8_SA(b, h) + aoff + m * 2048), *(const PG8_LAS bf16x8*)(lds + PG8_SA(b, h) + aoff + m * 2048 + 1024)); \
        else { _Pragma("unroll") for (int k = 0; k < 2; ++k) dst[m][k] = *(const PG8_LAS bf16x8*)(lds + PG8_SA(b, h) + aoff + m * 2048 + k * 1024); } } } while (0)
#define PG8_LDB(dst, b, h) do { _Pragma("unroll") for (int n = 0; n < 2; ++n) { \
        if constexpr (FP8) dst##8[n] = cat8(*(const PG8_LAS bf16x8*)(lds + PG8_SB(b, h) + boff + n * 2048), *(const PG8_LAS bf16x8*)(lds + PG8_SB(b, h) + boff + n * 2048 + 1024)); \
        else { _Pragma("unroll") for (int k = 0; k < 2; ++k) dst[n][k] = *(const PG8_LAS bf16x8*)(lds + PG8_SB(b, h) + boff + n * 2048 + k * 1024); } } } while (0)
#define PG8_MMA(ai, bj, At, Bt) do { __builtin_amdgcn_s_setprio(1); _Pragma("unroll") for (int m = 0; m < 4; ++m) _Pragma("unroll") for (int n = 0; n < 2; ++n) { \
        if constexpr (FP8) asm volatile("v_mfma_scale_f32_16x16x128_f8f6f4 %0, %1, %2, %0, %3, %3 op_sel_hi:[0,0,0]" : "+v"(acc[ai][bj][m][n]) : "v"(Bt##8[n]), "v"(At##8[m]), "v"(one_scale));     \
        else { _Pragma("unroll") for (int k = 0; k < 2; ++k) acc[ai][bj][m][n] = __builtin_amdgcn_mfma_f32_16x16x32_bf16(Bt[n][k], At[m][k], acc[ai][bj][m][n], 0, 0, 0); } } __builtin_amdgcn_s_setprio(0); } while (0)
#define PG8_WAIT_V(n) asm volatile("s_waitcnt vmcnt(" #n ")" ::: "memory")
#define PG8_WAIT_L(n) asm volatile("s_waitcnt lgkmcnt(" #n ")" ::: "memory")
#define PG8_BAR __builtin_amdgcn_s_barrier()
#define PG8_SCHED __builtin_amdgcn_sched_barrier(0)
#define PG8_GATHER_OFF(dst, u_) do { _Pragma("unroll") for (int _h = 0; _h < 2; ++_h) _Pragma("unroll") for (int _i = 0; _i < 2; ++_i) \
        dst[_h][_i] = (unsigned)g.rowidx[(u_).pm * BM + ((u_).hf < 0 ? _h : (u_).hf) * HALF + Rr[_i]] * (unsigned)(g.lda * 2) + cA2[_i]; } while (0)
    Unit cur, nxt; int ui = 0;
    if (!S.next(0, cur)) return;
    f32x4 acc[2][2][4][2];
#pragma unroll
    for (int a = 0; a < 2; ++a)
#pragma unroll
        for (int b = 0; b < 2; ++b)
#pragma unroll
            for (int m = 0; m < 4; ++m)
#pragma unroll
                for (int n = 0; n < 2; ++n) { acc[a][b][m][n] = (f32x4){0.f, 0.f, 0.f, 0.f}; if constexpr (FP8) asm volatile("" : "+v"(acc[a][b][m][n])); }
    const int one_scale = 0x7f7f7f7f;
    bf16x8 At[4][2], B0[2][2], B1[2][2]; v8i_t At8[4], B08[2], B18[2];
    if constexpr (GATHER) { PG8_GATHER_OFF(voffA, cur); }
    const size_t hstepA = (size_t)HALF * g.lda * 2;
    if (cur.hf >= 0) { voffA[1][0] = 0u; voffA[1][1] = 0u; }
    const char* cA = (const char*)g.A + (GATHER ? (size_t)0 : (size_t)cur.pm * tstepA + (cur.hf > 0 ? hstepA : (size_t)0)); const char* cB = (const char*)g.Bt + (size_t)cur.pn * tstepB;
    PG8_STAGE(PG8_SB(0, 0), cB, voffB); PG8_STAGE(PG8_SB(0, 1), cB + hstepB, voffB); PG8_STAGE(PG8_SA(0, 0), cA, voffA[0]); PG8_STAGE(PG8_SA(0, 1), cA, voffA[1]);
    if (wr == 1) PG8_BAR;
    PG8_WAIT_V(2); PG8_BAR;
    PG8_STAGE(PG8_SB(1, 0), cB + kstep, voffB); PG8_STAGE(PG8_SA(1, 0), cA + kstep, voffA[0]); PG8_STAGE(PG8_SB(1, 1), cB + hstepB + kstep, voffB);
    PG8_WAIT_V(6); PG8_BAR;
    for (;;) {
        const bool has_next = S.next(ui + 1, nxt);
        if constexpr (!GATHER) { const bool nh = has_next ? (nxt.hf >= 0) : (cur.hf >= 0); const unsigned hs = (unsigned)(HALF * g.lda * 2);
            nvoffA[1][0] = nh ? 0u : voffA[0][0] + hs; nvoffA[1][1] = nh ? 0u : voffA[0][1] + hs; }
        if constexpr (GATHER) { if (has_next) { PG8_GATHER_OFF(nvoffA, nxt); } else {
#pragma unroll
            for (int h = 0; h < 2; ++h)
#pragma unroll
                for (int i = 0; i < 2; ++i) nvoffA[h][i] = voffA[h][i]; } }
        const char* nA = GATHER ? (const char*)g.A : (has_next ? (const char*)g.A + (size_t)nxt.pm * tstepA + (nxt.hf > 0 ? hstepA : (size_t)0) : cA); const char* nB = has_next ? (const char*)g.Bt + (size_t)nxt.pn * tstepB : cB;
#pragma unroll 1
        for (int t = 0; t < nt; t += 2) {
            const bool last = (t == nt - 2);
            const char* a1 = cA + (size_t)(t + 1) * kstep;
            const char* a2 = last ? nA : cA + (size_t)(t + 2) * kstep; const char* b2 = last ? nB : cB + (size_t)(t + 2) * kstep;
            const char* a3 = a2 + kstep; const char* b3 = b2 + kstep;
            const bool sel = last;
            PG8_LDB(B0, 0, 0); PG8_LDB(B1, 0, 1); PG8_SCHED; PG8_LDA(At, 0, 0); PG8_STAGE(PG8_SA(1, 1), a1, voffA[1]);
            PG8_WAIT_V(8); PG8_WAIT_L(0); PG8_BAR; PG8_MMA(0, 0, At, B0); PG8_MMA(0, 1, At, B1); PG8_BAR; PG8_SCHED;
            PG8_LDA(At, 0, 1); PG8_STAGE(PG8_SB(0, 0), b2, voffB); PG8_STAGE(PG8_SB(0, 1), b2 + hstepB, voffB); PG8_STAGE_SEL(PG8_SA(0, 0), a2, sel, nvoffA[0], voffA[0]);
            PG8_WAIT_V(8); PG8_WAIT_L(0); PG8_BAR; if (cur.hf < 0) { PG8_MMA(1, 0, At, B0); PG8_MMA(1, 1, At, B1); } PG8_BAR; PG8_SCHED;
            PG8_LDB(B0, 1, 0); PG8_LDB(B1, 1, 1); PG8_SCHED; PG8_LDA(At, 1, 0); PG8_STAGE_SEL(PG8_SA(0, 1), a2, sel, nvoffA[1], voffA[1]);
            PG8_WAIT_V(8); PG8_WAIT_L(0); PG8_BAR; PG8_MMA(0, 0, At, B0); PG8_MMA(0, 1, At, B1); PG8_BAR; PG8_SCHED;
            PG8_LDA(At, 1, 1); PG8_STAGE(PG8_SB(1, 0), b3, voffB); PG8_STAGE(PG8_SB(1, 1), b3 + hstepB, voffB); PG8_STAGE_SEL(PG8_SA(1, 0), a3, sel, nvoffA[0], voffA[0]);
            PG8_WAIT_V(8); PG8_WAIT_L(0); PG8_BAR; if (cur.hf < 0) { PG8_MMA(1, 0, At, B0); PG8_MMA(1, 1, At, B1); } PG8_BAR; PG8_SCHED;
        }
        if constexpr (ALIGN_EPI) { if (wr == 0) PG8_BAR; }
        if constexpr (FP8) asm volatile("s_nop 15\n\ts_nop 7" ::: "memory");
        E(acc, cur, wr, wc, fr, fq);
        if (!has_next) break;
#pragma unroll
        for (int a = 0; a < 2; ++a)
#pragma unroll
            for (int b = 0; b < 2; ++b)
#pragma unroll
                for (int m = 0; m < 4; ++m)
#pragma unroll
                    for (int n = 0; n < 2; ++n) { acc[a][b][m][n] = (f32x4){0.f, 0.f, 0.f, 0.f}; if constexpr (FP8) asm volatile("" : "+v"(acc[a][b][m][n])); }
        cur = nxt; cA = nA; cB = nB; ++ui;
        if constexpr (!GATHER) { voffA[1][0] = nvoffA[1][0]; voffA[1][1] = nvoffA[1][1]; }
        if constexpr (GATHER) {
#pragma unroll
            for (int h = 0; h < 2; ++h)
#pragma unroll
                for (int i = 0; i < 2; ++i) voffA[h][i] = nvoffA[h][i]; }
        if constexpr (ALIGN_EPI) { if (wr == 1) PG8_BAR; }
    }
    PG8_WAIT_V(0);
    if constexpr (!ALIGN_EPI) { if (wr == 0) PG8_BAR; }
    PG8_BAR;
#undef PG8_SA
#undef PG8_SB
#undef PG8_STAGE
#undef PG8_STAGE_SEL
#undef PG8_LDA
#undef PG8_LDB
#undef PG8_MMA
#undef PG8_WAIT_V
#undef PG8_WAIT_L
#undef PG8_BAR
#undef PG8_SCHED
#undef PG8_GATHER_OFF
}
template <class F> struct EpiW {
    F f; int nnmod;
    __device__ __forceinline__ void operator()(f32x4 (&acc)[2][2][4][2], const Unit& u, int wr, int wc, int fr, int fq) const {
        const int pn = nnmod ? (u.pn % nnmod) : u.pn; const int row0 = u.pm * BM + wr * 64 + fr, col0 = pn * BM + wc * 32 + 4 * fq;
        float rsv[2][4]; int auxv[2][4]; typename F::Raw rw[2][4];
#pragma unroll
        for (int ai = 0; ai < 2; ++ai) { if (ai == 1 && u.hf >= 0) break;
#pragma unroll
            for (int m = 0; m < 4; ++m) { const int row = row0 + (u.hf < 0 ? ai : u.hf) * HALF + m * 16; rw[ai][m] = f.raw(row, fq); auxv[ai][m] = f.aux(row); } }
#pragma unroll
        for (int ai = 0; ai < 2; ++ai) { if (ai == 1 && u.hf >= 0) break;
#pragma unroll
            for (int m = 0; m < 4; ++m) rsv[ai][m] = f.fin(rw[ai][m]); }
        if constexpr (F::HAS_PRE) {
#pragma unroll
            for (int ai = 0; ai < 2; ++ai) { if (ai == 1 && u.hf >= 0) break;
#pragma unroll
                for (int m = 0; m < 4; ++m) { int row = row0 + (u.hf < 0 ? ai : u.hf) * HALF + m * 16; if ((m & 1) == 0) asm volatile("" : "+v"(row) :: "memory");
#pragma unroll
                    for (int bj = 0; bj < 2; ++bj) f.pre(row, col0 + bj * HALF, acc[ai][bj][m][0], acc[ai][bj][m][1]); } }
        }
#pragma unroll
        for (int ai = 0; ai < 2; ++ai) { if (ai == 1 && u.hf >= 0) break;
#pragma unroll
            for (int m = 0; m < 4; ++m) {
                int row = row0 + (u.hf < 0 ? ai : u.hf) * HALF + m * 16; asm volatile("" : "+v"(row) :: "memory");
#pragma unroll
                for (int bj = 0; bj < 2; ++bj) { const int col = col0 + bj * HALF;
                    float s = f(row, col, acc[ai][bj][m][0], acc[ai][bj][m][1], rsv[ai][m], auxv[ai][m]);
                    if constexpr (F::HAS_STAT) { s = fq_sum(s); if (fq == 0) f.stat(row, col, s); } }
            } }
    }
};
}


struct Raw32 { f32x4 a, b; };
__device__ __forceinline__ Raw32 raw32(const float* ss, int row, int fq) { Raw32 r; r.a = *(const f32x4*)(ss + (size_t)row * 32 + 8 * fq); r.b = *(const f32x4*)(ss + (size_t)row * 32 + 8 * fq + 4); return r; }
__device__ __forceinline__ float fin32(const Raw32& r) { return __builtin_amdgcn_rsqf(fq_sum(((r.a[0] + r.a[1]) + (r.a[2] + r.a[3])) + ((r.b[0] + r.b[1]) + (r.b[2] + r.b[3]))) * (1.0f / DM) + EPS); }
__device__ __forceinline__ float ssq8(f32x4 v0, f32x4 v1) { return ((v0[0] * v0[0] + v0[1] * v0[1]) + (v0[2] * v0[2] + v0[3] * v0[3])) + ((v1[0] * v1[0] + v1[1] * v1[1]) + (v1[2] * v1[2] + v1[3] * v1[3])); }
struct EpiIn {
    static constexpr bool HAS_STAT = true, HAS_PRE = false;
    const float* ssx; bf16_t *XL, *GY, *CQKV, *KR; float *SSQ, *SSKV; const float* tab;
    __device__ __forceinline__ int aux(int) const { return 0; }
    typedef Raw32 Raw;
    __device__ __forceinline__ Raw raw(int row, int fq) const { return raw32(ssx, row, fq); }
    __device__ __forceinline__ float fin(const Raw& r) const { return fin32(r); }
    __device__ __forceinline__ float operator()(int row, int col, f32x4 v0, f32x4 v1, float rs, int) const {
        if (col >= INC) return 0.f;
        v0 *= rs; v1 *= rs;
        if (col < 512) { store8bf_x(XL + (size_t)row * 512 + col, col, v0, v1); return 0.f; }
        if (col < 1024) { const int c = col - 512; f32x4 g0, g1;
#pragma unroll
            for (int e = 0; e < 4; ++e) { g0[e] = gelu_tanh(v0[e]); g1[e] = gelu_tanh(v1[e]); }
            store8bf_x(GY + (size_t)row * 512 + c, c, g0, g1); return 0.f; }
        if (col < 1408) { const int c = col - 1024; store8bf_x(CQKV + (size_t)row * 384 + c, c, v0, v1); return ssq8(v0, v1); }
        { const int i0 = col - 1408; f32x4 o1, o2;
#pragma unroll
          for (int e = 0; e < 4; ++e) { const float c = tab[(size_t)row * 32 + 2 * (i0 + e)], s = tab[(size_t)row * 32 + 2 * (i0 + e) + 1]; o1[e] = v0[e] * c - v1[e] * s; o2[e] = v1[e] * c + v0[e] * s; }
          store4bf(KR + (size_t)row * 32 + i0, o1); store4bf(KR + (size_t)row * 32 + 16 + i0, o2); return 0.f; }
    }
    __device__ __forceinline__ void stat(int row, int col, float s) const {
        if (col >= 1024 && col < 1280) SSQ[(size_t)row * 8 + ((col - 1024) >> 5)] = s;
        else if (col >= 1280 && col < 1408) SSKV[(size_t)row * 4 + ((col - 1280) >> 5)] = s;
    }
};
struct EpiQ {
    static constexpr bool HAS_STAT = false, HAS_PRE = false;
    const float* ssq; bf16_t* QF; const float* tab;
    __device__ __forceinline__ int aux(int) const { return 0; }
    typedef f32x2_t Raw;
    __device__ __forceinline__ Raw raw(int row, int fq) const { return *(const f32x2_t*)(ssq + (size_t)row * 8 + 2 * fq); }
    __device__ __forceinline__ float fin(const Raw& r) const { return __builtin_amdgcn_rsqf(fq_sum(r[0] + r[1]) * (1.0f / QLORA) + EPS) * QSCALE; }
    __device__ __forceinline__ float operator()(int row, int col, f32x4 v0, f32x4 v1, float rs, int) const {
        v0 *= rs; v1 *= rs;
        const int j = col % DQK;
        if (j < 64) { store8bf_x(QF + (size_t)row * QW + col, col, v0, v1); }
        else { const int i0 = j - 64; f32x4 o1, o2;
#pragma unroll
            for (int e = 0; e < 4; ++e) { const float c = tab[(size_t)row * 32 + 2 * (i0 + e)], s = tab[(size_t)row * 32 + 2 * (i0 + e) + 1]; o1[e] = v0[e] * c - v1[e] * s; o2[e] = v1[e] * c + v0[e] * s; }
            store4bf(QF + (size_t)row * QW + col, o1); store4bf(QF + (size_t)row * QW + col + 16, o2); }
        return 0.f;
    }
    __device__ __forceinline__ void stat(int, int, float) const {}
};
struct EpiKV {
    static constexpr bool HAS_STAT = false, HAS_PRE = false;
    const float* sskv; bf16_t *KN, *VT;
    __device__ __forceinline__ int aux(int) const { return 0; }
    typedef float Raw;
    __device__ __forceinline__ Raw raw(int row, int fq) const { return sskv[(size_t)row * 4 + fq]; }
    __device__ __forceinline__ float fin(const Raw& r) const { return __builtin_amdgcn_rsqf(fq_sum(r) * (1.0f / KVLORA) + EPS); }
    __device__ __forceinline__ float operator()(int row, int col, f32x4 v0, f32x4 v1, float rs, int) const {
        v0 *= rs; v1 *= rs;
        const int h = col >> 7, j = col & 127;
        if (j < 64) { bf16_t* kn = KN + (size_t)row * 512 + h * 64 + j; store8bf_x(kn, j, v0, v1); }
        else { const int d = j - 64, b = row / SEQ, s = row % SEQ; bf16_t* vt = VT + ((size_t)(b * NH + h) * VH + d) * SEQ + s;
#pragma unroll
            for (int e = 0; e < 4; ++e) { vt[(size_t)e * SEQ] = (bf16_t)f2bf(v0[e]); vt[(size_t)(e + 16) * SEQ] = (bf16_t)f2bf(v1[e]); } }
        return 0.f;
    }
    __device__ __forceinline__ void stat(int, int, float) const {}
};
struct EpiRes {
    static constexpr bool HAS_STAT = true, HAS_PRE = true;
    bf16_t* XR; unsigned char* X8; float* SSX; float accscale;
    typedef int Raw;
    __device__ __forceinline__ Raw raw(int, int) const { return 0; }
    __device__ __forceinline__ float fin(const Raw&) const { return 1.f; }
    __device__ __forceinline__ int aux(int) const { return 0; }
    __device__ __forceinline__ void pre(int row, int col, f32x4& v0, f32x4& v1) const {
        const size_t o = (size_t)row * DM + col;
        { const u32x2 a = *(const u32x2*)(XR + o), b = *(const u32x2*)(XR + o + 16);
            v0 = v0 * accscale + (f32x4){bf2f(a.x & 0xffff), bf2f(a.x >> 16), bf2f(a.y & 0xffff), bf2f(a.y >> 16)}; v1 = v1 * accscale + (f32x4){bf2f(b.x & 0xffff), bf2f(b.x >> 16), bf2f(b.y & 0xffff), bf2f(b.y >> 16)}; }
    }
    __device__ __forceinline__ float operator()(int row, int col, f32x4 a, f32x4 b, float, int) const {
        const size_t o = (size_t)row * DM + col;
        store8bf_x(XR + o, col, a, b);
        if (X8) { unsigned char* x8 = X8 + o; *(unsigned*)x8 = pk4_fp8(a[0] * F8_XS, a[1] * F8_XS, a[2] * F8_XS, a[3] * F8_XS); *(unsigned*)(x8 + 16) = pk4_fp8(b[0] * F8_XS, b[1] * F8_XS, b[2] * F8_XS, b[3] * F8_XS); }
        return ssq8(a, b);
    }
    __device__ __forceinline__ void stat(int row, int col, float s) const { SSX[(size_t)row * 32 + (col >> 5)] = s; }
};
template <bool F8> struct GURaw { typedef Raw32 T; }; template <> struct GURaw<true> { typedef float T; };
template <bool F8> struct EpiGU {
    static constexpr bool HAS_STAT = false, HAS_PRE = false;
    const float* ssx; const int* rowtok; bf16_t* ACT; int ldact;
    __device__ __forceinline__ int aux(int) const { return 0; }
    typedef typename GURaw<F8>::T Raw;
    __device__ __forceinline__ Raw raw(int row, int fq) const { if constexpr (F8) return ssx[row]; else return raw32(ssx, row, fq); }
    __device__ __forceinline__ float fin(const Raw& r) const { if constexpr (F8) return r; else return fin32(r); }
    __device__ __forceinline__ float operator()(int row, int col, f32x4 v0, f32x4 v1, float rs, int) const {
        f32x4 o;
        const float sc = F8 ? rs * (1.0f / (F8_XS * F8_WS)) : rs;
#pragma unroll
        for (int e = 0; e < 4; ++e) { const float g = v0[e] * sc, u = v1[e] * sc; o[e] = g * sigmoidf_(g) * u; }
        if (F8) *(unsigned*)((unsigned char*)ACT + (size_t)row * ldact + (col >> 5) * 16 + (col & 31)) = pk4_fp8(o[0] * F8_AS, o[1] * F8_AS, o[2] * F8_AS, o[3] * F8_AS);
        else store4bf_x(ACT + (size_t)row * ldact + (col >> 5) * 16 + (col & 31), col, o);
        return 0.f;
    }
    __device__ __forceinline__ void stat(int, int, float) const {}
};
struct EpiED {
    static constexpr bool HAS_STAT = false, HAS_PRE = false;
    const float* roww; const int* rowslot; bf16_t* Y;
    typedef float Raw;
    __device__ __forceinline__ Raw raw(int row, int) const { return roww[row]; }
    __device__ __forceinline__ float fin(const Raw& r) const { return r; }
    __device__ __forceinline__ int aux(int row) const { return rowslot[row]; }
    __device__ __forceinline__ float operator()(int, int col, f32x4 v0, f32x4 v1, float w, int slot) const {
        if (slot < 0) return 0.f;
        const float ws_ = w * (1.0f / (F8_AS * F8_WS)); store8bf_x(Y + (size_t)slot * DM + col, col, v0 * ws_, v1 * ws_); return 0.f;
    }
    __device__ __forceinline__ void stat(int, int, float) const {}
};

template <class F, bool ALIGN>
__device__ __forceinline__ void gemm_static(int wv, const bf16_t* A, int lda, const bf16_t* Bt, int ldb, int M, int N, int K, const F& f, int bid, int nb, unsigned char* smem) {
    pg8::Gemm g{A, Bt, lda, ldb, K, nullptr}; pg8::StaticOrder S; S.init(M / 256, N / 256, nb, bid); pg8::EpiW<F> E{f, 0};
    pg8::gemm_phase<pg8::EpiW<F>, pg8::StaticOrder, ALIGN, false>(wv, (PG8_LAS unsigned char*)smem, g, S, E);
}

__device__ __forceinline__ void expert_offsets(const int* cnt, int (&off)[NE + 1]) {
    int o = 0;
#pragma unroll
    for (int e = 0; e < NE; ++e) { off[e] = o; o += (cnt[e] + 255) & ~255; }
    off[NE] = o;
}

constexpr int XCS_LD = 520;
constexpr int LRU_XL = 0, LRU_XCS = 35 * 1024, LRU_GR = LRU_XCS + 16 * XCS_LD * 2, LRU_GI = LRU_GR + 16 * 512 * 4, LRU_GY = LRU_GI + 16 * 512 * 4, LRU_LDS = LRU_GY + 32 * 1024;
template <bool FIN>
__device__ __forceinline__ void lru_phase(PP p, int wv, int l, int bid, int nb, unsigned char* smem) {
    const int c = otid(wv), lane = c & 63, fr = lane & 15, fq = lane >> 4;
    unsigned char* ws = p->ws;
    const bf16_t* XL = (const bf16_t*)(ws + WS_XL); const bf16_t* GY = (const bf16_t*)(ws + WS_GY); bf16_t* MIX = (bf16_t*)(ws + WS_MIX); float* SUM = (float*)(ws + WS_SUM); unsigned* LAU = (unsigned*)(ws + WS_LAU);
    bf16_t* xls = (bf16_t*)(smem + LRU_XL); bf16_t* xcs = (bf16_t*)(smem + LRU_XCS); float* gr = (float*)(smem + LRU_GR); float* gi = (float*)(smem + LRU_GI); bf16_t* gys = (bf16_t*)(smem + LRU_GY);
    bf16x8 wf[2][4][2];
    { const bf16_t* lw = (const bf16_t*)(ws + WS_LW) + (size_t)((l * 8 + wv) * 2) * 4096;
#pragma unroll
      for (int w = 0; w < 2; ++w)
#pragma unroll
          for (int dt = 0; dt < 4; ++dt)
#pragma unroll
              for (int ks = 0; ks < 2; ++ks) wf[w][dt][ks] = *(const bf16x8*)(lw + (size_t)w * 4096 + (dt * 16 + fr) * 64 + ks * 32 + fq * 8); }
    const float ba = p->lru_ba[l * LRU_W + c], bx = p->lru_bx[l * LRU_W + c];
    const float lam = p->lru_lambda[l * LRU_W + c]; const float sp8 = -8.0f * 1.4426950408889634f * log1pf(expf(-lam));
    const float cw0 = p->conv_w[(l * 4 + 0) * LRU_W + c], cw1 = p->conv_w[(l * 4 + 1) * LRU_W + c], cw2 = p->conv_w[(l * 4 + 2) * LRU_W + c], cw3 = p->conv_w[(l * 4 + 3) * LRU_W + c], cb = p->conv_b[l * LRU_W + c];
    for (int ch = bid; ch < T / 64; ch += nb) {
        const int t0 = ch * 64, s0 = t0 % SEQ;
        u32x4 pre[5], pg[4];
#define LRU_LOAD(hf) do { _Pragma("unroll") for (int j = 0; j < 5; ++j) { const int pc = c + 512 * j; const int row = pc >> 6, tk = t0 + 32 * (hf) - 3 + row; \
            pre[j] = (u32x4){0u, 0u, 0u, 0u}; if (pc < 2240 && !((hf) == 0 && s0 == 0 && row < 3)) pre[j] = *(const u32x4*)(XL + (size_t)tk * 512 + (pc & 63) * 8); } \
            if (FIN) { _Pragma("unroll") for (int j = 0; j < 4; ++j) { const int pc = c + 512 * j; pg[j] = *(const u32x4*)(GY + (size_t)(t0 + 32 * (hf) + (pc >> 6)) * 512 + (pc & 63) * 8); } } } while (0)
#define LRU_STORE() do { _Pragma("unroll") for (int j = 0; j < 5; ++j) { const int pc = c + 512 * j; if (pc < 2240) *(u32x4*)(xls + pc * 8) = pre[j]; } \
            if (FIN) { _Pragma("unroll") for (int j = 0; j < 4; ++j) *(u32x4*)(gys + (c + 512 * j) * 8) = pg[j]; } } while (0)
        LRU_LOAD(0);
        float h = 0.f, Aacc = 1.f;
        if (FIN) { const int cfirst = (t0 / SEQ) * (SEQ / 64);
            for (int cc = cfirst; cc < ch; cc += 8) { float a_[8], h_[8];
#pragma unroll
                for (int q = 0; q < 8; ++q) { const bool ok = cc + q < ch; a_[q] = ok ? SUM[(size_t)(cc + q) * 1024 + c] : 1.f; h_[q] = ok ? SUM[(size_t)(cc + q) * 1024 + 512 + c] : 0.f; }
#pragma unroll
                for (int q = 0; q < 8; ++q) h = a_[q] * h + h_[q]; } }
        LRU_STORE();
        __syncthreads();
#pragma unroll 1
        for (int hf = 0; hf < 2; ++hf) {
            if (hf == 0) LRU_LOAD(1);
#pragma unroll 1
            for (int sub = 0; sub < 2; ++sub) {
                const int tb = t0 + 32 * hf + 16 * sub;
                const bf16_t* xr = xls + (16 * sub) * 512 + c;
                { float x0 = bf2f(xr[0]), x1 = bf2f(xr[512]), x2 = bf2f(xr[1024]);
#pragma unroll 4
                  for (int tt = 0; tt < 16; ++tt) { const float x3 = bf2f(xr[(tt + 3) * 512]); const float xcv = cb + cw0 * x0 + cw1 * x1 + cw2 * x2 + cw3 * x3; x0 = x1; x1 = x2; x2 = x3; xcs[tt * XCS_LD + c] = (bf16_t)f2bf(xcv); } }
                __syncthreads();
                { f32x4 ar[4], ai[4];
#pragma unroll
                  for (int dt = 0; dt < 4; ++dt) { ar[dt] = (f32x4){0.f, 0.f, 0.f, 0.f}; ai[dt] = (f32x4){0.f, 0.f, 0.f, 0.f}; }
#pragma unroll
                  for (int ks = 0; ks < 2; ++ks) { const bf16x8 af = *(const bf16x8*)(xcs + fr * XCS_LD + wv * 64 + ks * 32 + fq * 8);
#pragma unroll
                      for (int dt = 0; dt < 4; ++dt) { ar[dt] = __builtin_amdgcn_mfma_f32_16x16x32_bf16(af, wf[0][dt][ks], ar[dt], 0, 0, 0); ai[dt] = __builtin_amdgcn_mfma_f32_16x16x32_bf16(af, wf[1][dt][ks], ai[dt], 0, 0, 0); } }
#pragma unroll
                  for (int dt = 0; dt < 4; ++dt)
#pragma unroll
                      for (int r = 0; r < 4; ++r) { gr[(4 * fq + r) * 512 + wv * 64 + dt * 16 + fr] = ar[dt][r]; gi[(4 * fq + r) * 512 + wv * 64 + dt * 16 + fr] = ai[dt][r]; } }
                __syncthreads();
                { float x0 = bf2f(xr[0]), x1 = bf2f(xr[512]), x2 = bf2f(xr[1024]);
#pragma unroll 4
                  for (int tt = 0; tt < 16; ++tt) {
                    const float x3 = bf2f(xr[(tt + 3) * 512]); const float xcv = cb + cw0 * x0 + cw1 * x1 + cw2 * x2 + cw3 * x3; x0 = x1; x1 = x2; x2 = x3;
                    const float r = sigmoidf_(gr[tt * 512 + c] + ba), ig = sigmoidf_(gi[tt * 512 + c] + bx);
                    const float a = __builtin_amdgcn_exp2f(sp8 * r); float mult = __builtin_amdgcn_sqrtf(1.0f - a * a);
                    const int t = tb + tt; if ((t % SEQ) == 0) mult = 1.0f;
                    const float u = mult * (ig * xcv);
                    h = a * h + u; Aacc *= a;
                    if (!FIN) LAU[(size_t)t * 512 + c] = pk2(sp8 * r, u);
                    if (FIN) MIX[(size_t)t * DM + c] = (bf16_t)f2bf(h * bf2f(gys[(16 * sub + tt) * 512 + c]));
                  } }
                __syncthreads();
            }
            if (hf == 0) { LRU_STORE(); __syncthreads(); }
        }
        if (!FIN) { SUM[(size_t)ch * 1024 + c] = Aacc; SUM[(size_t)ch * 1024 + 512 + c] = h; }
#undef LRU_LOAD
#undef LRU_STORE
    }
}

__device__ __forceinline__ void lru_sum_phase(PP p, int wv, int l, int bid, int nb, unsigned char* smem) {
    const int tid = otid(wv), lane = tid & 63, fr = lane & 15, fq = lane >> 4;
    unsigned char* ws = p->ws;
    const bf16_t* XL = (const bf16_t*)(ws + WS_XL); float* SUM = (float*)(ws + WS_SUM); unsigned* LAU = (unsigned*)(ws + WS_LAU);
    float* cwl = (float*)smem;
    for (int i = tid; i < 5 * LRU_W; i += NTHR) { const int k = i >> 9, c = i & 511; cwl[i] = k < 4 ? p->conv_w[(l * 4 + k) * LRU_W + c] : p->conv_b[l * LRU_W + c]; }
    unsigned char* wl = smem + 10240 + wv * 16384;
    { const bf16_t* lw = (const bf16_t*)(ws + WS_LW) + (size_t)((l * 8 + wv) * 2) * 4096;
#pragma unroll
      for (int j = 0; j < 16; ++j) { const int pc = lane + 64 * j, row = pc >> 3, piece = pc & 7; *(u32x4*)(wl + row * 128 + ((piece ^ (row & 7)) << 4)) = *(const u32x4*)(lw + row * 64 + piece * 8); } }
    float ba[4], bx[4], sp8[4];
#pragma unroll
    for (int dt = 0; dt < 4; ++dt) { const int c = l * LRU_W + wv * 64 + dt * 16 + fr; ba[dt] = p->lru_ba[c]; bx[dt] = p->lru_bx[c]; sp8[dt] = -8.0f * 1.4426950408889634f * log1pf(expf(-p->lru_lambda[c])); }
    bf16x8 idf[2];
#pragma unroll
    for (int q = 0; q < 2; ++q) { const int j = 16 * q + fr - 8 * fq; u32x4 w = {0u, 0u, 0u, 0u};
#pragma unroll
        for (int d = 0; d < 4; ++d) { if (j == 2 * d) w[d] = 0x3F80u; if (j == 2 * d + 1) w[d] = 0x3F800000u; }
        idf[q] = __builtin_bit_cast(bf16x8, w); }
    __syncthreads();
    const int cbase = wv * 64 + 8 * fq;
    for (int ch = bid; ch < T / 64; ch += nb) {
        const int t0 = ch * 64; const bool seqstart = (t0 % SEQ) == 0;
        float Ar[4] = {1.f, 1.f, 1.f, 1.f}, Hr[4] = {0.f, 0.f, 0.f, 0.f};
        u32x4 xc_[2][4];
#define LRS_LOAD(dst, sub_) do { _Pragma("unroll") for (int ks = 0; ks < 2; ++ks) _Pragma("unroll") for (int tap = 0; tap < 4; ++tap) { const int rel = 16 * (sub_) + fr - 3 + tap; \
            dst[ks][tap] = (u32x4){0u, 0u, 0u, 0u}; if (!(seqstart && rel < 0)) dst[ks][tap] = *(const u32x4*)(XL + (size_t)(t0 + rel) * LRU_W + cbase + 32 * ks); } } while (0)
        LRS_LOAD(xc_, 0);
#pragma unroll 1
        for (int sub = 0; sub < 4; ++sub) {
            unsigned oz = 0u; asm volatile("" : "+v"(oz)); const LAS float* cwo = (const LAS float*)((const LAS unsigned char*)smem + oz); const LAS unsigned char* wlo = (const LAS unsigned char*)smem + oz + 10240 + wv * 16384;
            bf16x8 af[2];
#pragma unroll
            for (int ks = 0; ks < 2; ++ks) { u32x4 pk;
#pragma unroll
                for (int hj = 0; hj < 2; ++hj) { const LAS float* wp = cwo + cbase + 32 * ks + 4 * hj; f32x4 acc = *(const LAS f32x4*)(wp + 4 * LRU_W);
#pragma unroll
                    for (int tap = 0; tap < 4; ++tap) { const unsigned d0 = xc_[ks][tap][2 * hj], d1 = xc_[ks][tap][2 * hj + 1];
                        const f32x4 xv = {__uint_as_float(d0 << 16), __uint_as_float(d0 & 0xffff0000u), __uint_as_float(d1 << 16), __uint_as_float(d1 & 0xffff0000u)};
                        acc += *(const LAS f32x4*)(wp + tap * LRU_W) * xv; }
                    pk[2 * hj] = pk2(acc[0], acc[1]); pk[2 * hj + 1] = pk2(acc[2], acc[3]); }
                af[ks] = __builtin_bit_cast(bf16x8, pk); }
            if (sub < 3) LRS_LOAD(xc_, sub + 1);
            f32x4 ar[4], ai[4], xd[4];
#pragma unroll
            for (int dt = 0; dt < 4; ++dt) { ar[dt] = (f32x4){0.f, 0.f, 0.f, 0.f}; ai[dt] = (f32x4){0.f, 0.f, 0.f, 0.f}; }
#pragma unroll
            for (int ks = 0; ks < 2; ++ks)
#pragma unroll
                for (int dt = 0; dt < 4; ++dt) { const LAS unsigned char* wp_ = wlo + (dt * 16 + fr) * 128 + (((ks * 4 + fq) ^ (fr & 7)) << 4);
                    ar[dt] = __builtin_amdgcn_mfma_f32_16x16x32_bf16(af[ks], *(const LAS bf16x8*)wp_, ar[dt], 0, 0, 0); ai[dt] = __builtin_amdgcn_mfma_f32_16x16x32_bf16(af[ks], *(const LAS bf16x8*)(wp_ + 64 * 128), ai[dt], 0, 0, 0); }
#pragma unroll
            for (int dt = 0; dt < 4; ++dt) xd[dt] = __builtin_amdgcn_mfma_f32_16x16x32_bf16(af[dt >> 1], idf[dt & 1], (f32x4){0.f, 0.f, 0.f, 0.f}, 0, 0, 0);
            u32x4* lp = (u32x4*)(LAU + ((size_t)((t0 >> 4) + sub) * 8 + wv) * 1024 + lane * 16);
#pragma unroll
            for (int dt = 0; dt < 4; ++dt) { float Al = 1.f, Hl = 0.f; u32x4 lw4;
#pragma unroll
                for (int r = 0; r < 4; ++r) {
                    const float rg = sigmoidf_(ar[dt][r] + ba[dt]), ig = sigmoidf_(ai[dt][r] + bx[dt]);
                    const float la = sp8[dt] * rg, a = __builtin_amdgcn_exp2f(la); float mult = __builtin_amdgcn_sqrtf(1.0f - a * a);
                    if (r == 0) { if (seqstart && sub == 0 && fq == 0) mult = 1.0f; }
                    const float u = mult * (ig * xd[dt][r]);
                    Hl = a * Hl + u; Al *= a;
                    lw4[r] = pk2(la, u);
                }
                lp[dt] = lw4;
                { const auto sa = __builtin_amdgcn_permlane16_swap(__float_as_uint(Al), __float_as_uint(Al), false, false), sh = __builtin_amdgcn_permlane16_swap(__float_as_uint(Hl), __float_as_uint(Hl), false, false);
                  Hl = __uint_as_float(sh[0]) * __uint_as_float(sa[1]) + __uint_as_float(sh[1]); Al = __uint_as_float(sa[0]) * __uint_as_float(sa[1]); }
                { const auto sa = __builtin_amdgcn_permlane32_swap(__float_as_uint(Al), __float_as_uint(Al), false, false), sh = __builtin_amdgcn_permlane32_swap(__float_as_uint(Hl), __float_as_uint(Hl), false, false);
                  Hl = __uint_as_float(sh[0]) * __uint_as_float(sa[1]) + __uint_as_float(sh[1]); Al = __uint_as_float(sa[0]) * __uint_as_float(sa[1]); }
                Hr[dt] = Al * Hr[dt] + Hl; Ar[dt] *= Al; }
        }
#undef LRS_LOAD
        if (fq == 0) {
#pragma unroll
            for (int dt = 0; dt < 4; ++dt) { SUM[(size_t)ch * 1024 + wv * 64 + dt * 16 + fr] = Ar[dt]; SUM[(size_t)ch * 1024 + 512 + wv * 64 + dt * 16 + fr] = Hr[dt]; } }
    }
}

__device__ __forceinline__ void lru_scan_phase(PP p, int wv, int bid, int nb) {
    const int c = otid(wv); unsigned char* ws = p->ws;
    const bf16_t* GY = (const bf16_t*)(ws + WS_GY); bf16_t* MIX = (bf16_t*)(ws + WS_MIX); const float* SUM = (const float*)(ws + WS_SUM); const unsigned* LAU = (const unsigned*)(ws + WS_LAU);
    const int lofs = (c >> 6) * 1024 + (c & 15) * 16 + ((c >> 4) & 3) * 4;
    for (int ch = bid; ch < T / 64; ch += nb) {
        const int t0 = ch * 64; float h = 0.f;
        { const int cfirst = (t0 / SEQ) * (SEQ / 64);
          for (int cc = cfirst; cc < ch; cc += 8) { float a_[8], h_[8];
#pragma unroll
              for (int q = 0; q < 8; ++q) { const bool ok = cc + q < ch; a_[q] = ok ? SUM[(size_t)(cc + q) * 1024 + c] : 1.f; h_[q] = ok ? SUM[(size_t)(cc + q) * 1024 + 512 + c] : 0.f; }
#pragma unroll
              for (int q = 0; q < 8; ++q) h = a_[q] * h + h_[q]; } }
#pragma unroll 1
        for (int sub = 0; sub < 4; ++sub) { u32x4 lu[4]; unsigned short gy[16];
#pragma unroll
            for (int g4 = 0; g4 < 4; ++g4) lu[g4] = *(const u32x4*)(LAU + (size_t)((t0 >> 4) + sub) * 8192 + lofs + g4 * 256);
#pragma unroll
            for (int tt = 0; tt < 16; ++tt) gy[tt] = GY[(size_t)(t0 + 16 * sub + tt) * 512 + c];
#pragma unroll
            for (int tt = 0; tt < 16; ++tt) { const unsigned w = lu[tt >> 2][tt & 3]; const float a = __builtin_amdgcn_exp2f(bf2f((unsigned short)(w & 0xffffu))), u = bf2f((unsigned short)(w >> 16));
                h = a * h + u; MIX[(size_t)(t0 + 16 * sub + tt) * DM + c] = (bf16_t)f2bf(h * bf2f(gy[tt])); }
        }
    }
}

__device__ __forceinline__ int pi32(int r) { return (r & 0x13) | ((r & 4) << 1) | ((r & 8) >> 1); }
__device__ __forceinline__ unsigned cvtpk(float lo, float hi) { return pk2(lo, hi); }
constexpr int AT_KN = 0, AT_KR = 8192, AT_VT = 12288, AT_SLOT = 20480, AT_NSLOT = 4;
constexpr float AT_THR = 8.0f;
__device__ __forceinline__ float max3f(float a, float b, float c) { float r; asm("v_max3_f32 %0, %1, %2, %3" : "=v"(r) : "v"(a), "v"(b), "v"(c)); return r; }
#define AT_WAITV(n) asm volatile("s_waitcnt vmcnt(" #n ")" ::: "memory")
__device__ __forceinline__ void attn_unit(int wv, int b, int h, int qb, const bf16_t* QF, const bf16_t* KN, const bf16_t* KR, const bf16_t* VT, bf16_t* MIX, LAS unsigned char* lds) {
    const int tid = otid(wv), lane = tid & 63, wid = __builtin_amdgcn_readfirstlane(tid >> 6), r32 = lane & 31, hi = lane >> 5;
    const size_t rowbase = (size_t)b * SEQ; const int q0 = qb * 256, NT = (q0 + 256) / 64;
    const int krow = 8 * wid + (lane >> 3), kch = (lane & 7) ^ ((krow >> 1) & 7);
    const bf16_t* ksrc = KN + (rowbase + krow) * 512 + h * 64 + kch * 8;
    const bf16_t* vsrc = VT + ((size_t)(b * NH + h) * VH + krow) * SEQ + kch * 8;
    const int rrow = 16 * (wid & 3) + (lane >> 2), rch = (lane & 3) ^ ((rrow >> 2) & 3);
    const bf16_t* rsrc = KR + (rowbase + rrow) * 32 + rch * 8;
    const unsigned wofs = (unsigned)wid * 1024u;
#define AT_ISSUE(t, slot) do { LAS unsigned char* sb_ = lds + (slot) * AT_SLOT; \
        __builtin_amdgcn_global_load_lds((const unsigned*)(ksrc + (size_t)(t) * 64 * 512), (LAS unsigned*)(sb_ + AT_KN + wofs), 16, 0, 0); \
        __builtin_amdgcn_global_load_lds((const unsigned*)(vsrc + (size_t)(t) * 64), (LAS unsigned*)(sb_ + AT_VT + wofs), 16, 0, 0); \
        if (wid < 4) __builtin_amdgcn_global_load_lds((const unsigned*)(rsrc + (size_t)(t) * 64 * 32), (LAS unsigned*)(sb_ + AT_KR + wofs), 16, 0, 0); } while (0)
    AT_ISSUE(0, 0); AT_ISSUE(1, 1);
    bf16x8 qf[6];
#pragma unroll
    for (int s = 0; s < 6; ++s) qf[s] = *(const bf16x8*)(QF + (rowbase + q0 + 32 * wid + r32) * QW + h * DQK + 16 * s + 8 * hi);
    __builtin_amdgcn_s_waitcnt(0x0F70);
    const int pr = pi32(r32);
    int kno[2], kro[2], vto[2];
#pragma unroll
    for (int hf = 0; hf < 2; ++hf) { const int row = 32 * hf + pr; kno[hf] = AT_KN + row * 128 + ((hi ^ ((row >> 1) & 7)) << 4); kro[hf] = AT_KR + row * 64 + ((hi ^ ((row >> 2) & 3)) << 4);
        const int dr = 32 * hf + r32; vto[hf] = AT_VT + dr * 128 + ((hi ^ ((dr >> 1) & 7)) << 4); }
    f32x16 o0 = {}, o1 = {}, negm = {}; float m = 0.f, lsum = 0.f; bool first = true;
    const int qg = q0 + 32 * wid + r32; const unsigned lds_base = (unsigned)(size_t)lds;
    for (int tp = 0; tp < NT; tp += 2) {
        AT_WAITV(0);
        __builtin_amdgcn_s_barrier(); asm volatile("" ::: "memory");
        if (tp + 2 < NT) { const int sn = 2 * (((tp >> 1) + 1) & 1); AT_ISSUE(tp + 2, sn); AT_ISSUE(tp + 3, sn + 1); }
#pragma unroll 1
      for (int sub = 0; sub < 2; ++sub) {
        const int t = tp + sub, slot = 2 * ((tp >> 1) & 1) + sub;
        const int kv0 = 64 * t;
        if (kv0 <= q0 + 32 * wid + 31) {
            const unsigned sba = lds_base + (unsigned)slot * AT_SLOT;
            bf16x8 kf[12], vf[8];
#define AT_DSR(dst, addr, off) asm volatile("ds_read_b128 %0, %1 offset:%2" : "=v"(dst) : "v"(addr), "i"(off))
#pragma unroll
            for (int s = 0; s < 4; ++s) { const unsigned ka = sba + (unsigned)(kno[0] ^ (s << 5)); AT_DSR(kf[2 * s], ka, 0); AT_DSR(kf[2 * s + 1], ka, 4096); }
#pragma unroll
            for (int s = 0; s < 2; ++s) { const unsigned ka = sba + (unsigned)(kro[0] ^ (s << 5)); AT_DSR(kf[8 + 2 * s], ka, 0); AT_DSR(kf[8 + 2 * s + 1], ka, 2048); }
            f32x16 st0, st1;
#define AT_KSTEP(s, n) do { asm volatile("s_waitcnt lgkmcnt(" #n ")" : "+v"(kf[2 * (s)]), "+v"(kf[2 * (s) + 1])); __builtin_amdgcn_sched_barrier(0); \
                st0 = __builtin_amdgcn_mfma_f32_32x32x16_bf16(kf[2 * (s)], qf[s], st0, 0, 0, 0); st1 = __builtin_amdgcn_mfma_f32_32x32x16_bf16(kf[2 * (s) + 1], qf[s], st1, 0, 0, 0); } while (0)
            { asm volatile("s_waitcnt lgkmcnt(10)" : "+v"(kf[0]), "+v"(kf[1])); __builtin_amdgcn_sched_barrier(0);
              st0 = __builtin_amdgcn_mfma_f32_32x32x16_bf16(kf[0], qf[0], negm, 0, 0, 0); st1 = __builtin_amdgcn_mfma_f32_32x32x16_bf16(kf[1], qf[0], negm, 0, 0, 0); }
            AT_KSTEP(1, 8); AT_KSTEP(2, 6); AT_KSTEP(3, 4); AT_KSTEP(4, 2); AT_KSTEP(5, 0);
            asm volatile("s_nop 15\n\ts_nop 7" : "+v"(st0), "+v"(st1));
#pragma unroll
            for (int ks = 0; ks < 4; ++ks) { const unsigned va = sba + (unsigned)(vto[0] ^ (ks << 5)); AT_DSR(vf[2 * ks], va, 0); AT_DSR(vf[2 * ks + 1], va, 4096); }
            if (kv0 + 63 > q0 + 32 * wid) {
                const int dq = qg - kv0 - 8 * hi;
#pragma unroll
                for (int reg = 0; reg < 16; ++reg) { const int cb = (reg & 3) + 4 * ((reg >> 2) & 1) + 16 * (reg >> 3); if (cb > dq) st0[reg] = -INFINITY; if (cb + 32 > dq) st1[reg] = -INFINITY; }
            }
            float mx = max3f(st0[0], st0[1], st1[0]), mx2 = max3f(st0[2], st0[3], st1[1]); mx = max3f(mx, st1[2], st1[3]);
#pragma unroll
            for (int reg = 4; reg < 16; reg += 4) { mx = max3f(mx, st0[reg], st0[reg + 1]); mx2 = max3f(mx2, st0[reg + 2], st0[reg + 3]); mx = max3f(mx, st1[reg], st1[reg + 1]); mx2 = max3f(mx2, st1[reg + 2], st1[reg + 3]); }
            mx = max3f(mx, mx2, mx2);
            { const auto rr = __builtin_amdgcn_permlane32_swap(__float_as_uint(mx), __float_as_uint(mx), false, false); mx = max3f(__uint_as_float(rr[0]), __uint_as_float(rr[1]), __uint_as_float(rr[1])); }
            if (first || __any(mx > AT_THR)) {
                const float dl = first ? mx : fmaxf(mx, 0.f); const float alpha = first ? 0.f : __builtin_amdgcn_exp2f(-dl); first = false; m += dl; lsum *= alpha;
#pragma unroll
                for (int reg = 0; reg < 16; ++reg) { st0[reg] -= dl; st1[reg] -= dl; o0[reg] *= alpha; o1[reg] *= alpha; negm[reg] = -m; }
            }
            float ps = 0.f;
#pragma unroll
            for (int reg = 0; reg < 16; ++reg) { st0[reg] = __builtin_amdgcn_exp2f(st0[reg]); st1[reg] = __builtin_amdgcn_exp2f(st1[reg]); ps += st0[reg] + st1[reg]; }
            lsum += ps;
            u32x4 pw[4];
#pragma unroll
            for (int q = 0; q < 4; ++q) { pw[0][q] = cvtpk(st0[2 * q], st0[2 * q + 1]); pw[1][q] = cvtpk(st0[8 + 2 * q], st0[8 + 2 * q + 1]); pw[2][q] = cvtpk(st1[2 * q], st1[2 * q + 1]); pw[3][q] = cvtpk(st1[8 + 2 * q], st1[8 + 2 * q + 1]); }
#define AT_VSTEP(ks, n) do { asm volatile("s_waitcnt lgkmcnt(" #n ")" : "+v"(vf[2 * (ks)]), "+v"(vf[2 * (ks) + 1])); __builtin_amdgcn_sched_barrier(0); const bf16x8 pb = __builtin_bit_cast(bf16x8, pw[ks]); \
                o0 = __builtin_amdgcn_mfma_f32_32x32x16_bf16(vf[2 * (ks)], pb, o0, 0, 0, 0); o1 = __builtin_amdgcn_mfma_f32_32x32x16_bf16(vf[2 * (ks) + 1], pb, o1, 0, 0, 0); } while (0)
            AT_VSTEP(0, 6); AT_VSTEP(1, 4); AT_VSTEP(2, 2); AT_VSTEP(3, 0);
#undef AT_DSR
#undef AT_KSTEP
#undef AT_VSTEP
        }
        asm volatile("s_waitcnt lgkmcnt(0)" ::: "memory");
      }
    }
    { const auto rr = __builtin_amdgcn_permlane32_swap(__float_as_uint(lsum), __float_as_uint(lsum), false, false); lsum = __uint_as_float(rr[0]) + __uint_as_float(rr[1]); }
    const float il = 1.0f / lsum; bf16_t* op = MIX + (rowbase + q0 + 32 * wid + r32) * DM + 512 + h * VH;
#pragma unroll
    for (int g = 0; g < 4; ++g) { const int dd = 8 * g + 4 * hi;
        store4bf(op + dd, (f32x4){o0[4 * g] * il, o0[4 * g + 1] * il, o0[4 * g + 2] * il, o0[4 * g + 3] * il});
        store4bf(op + 32 + dd, (f32x4){o1[4 * g] * il, o1[4 * g + 1] * il, o1[4 * g + 2] * il, o1[4 * g + 3] * il}); }
    AT_WAITV(0);
    __builtin_amdgcn_s_barrier(); asm volatile("" ::: "memory");
#undef AT_ISSUE
}
__device__ __forceinline__ void attn_phase(PP p, int wv, int bid, int nb, unsigned char* smem) {
    unsigned char* ws = p->ws;
    const bf16_t* QF = (const bf16_t*)(ws + WS_QF); const bf16_t* KN = (const bf16_t*)(ws + WS_KF); const bf16_t* KR = (const bf16_t*)(ws + WS_KR); const bf16_t* VT = (const bf16_t*)(ws + WS_VT); bf16_t* MIX = (bf16_t*)(ws + WS_MIX);
    const int vcu = (nb % 8 == 0) ? (bid % 8) * (nb / 8) + bid / 8 : bid;
    for (int pr = vcu; pr < BATCH * NH * 8; pr += nb) {
        const int bh = pr >> 3, s = pr & 7;
        attn_unit(wv, bh / NH, bh % NH, 15 - s, QF, KN, KR, VT, MIX, (LAS unsigned char*)smem);
        attn_unit(wv, bh / NH, bh % NH, s, QF, KN, KR, VT, MIX, (LAS unsigned char*)smem);
    }
}

__device__ void router_phase(PP p, int wv, int bid, int nb, unsigned char* smem) {
    const int tid = otid(wv), lane = tid & 63, wid = tid >> 6;
    unsigned char* ws = p->ws; const bf16_t* X = (const bf16_t*)(ws + WS_XB); int* cnt = (int*)(ws + WS_CTL);
    int* TOPE = (int*)(ws + WS_TOPE); float* TOPW = (float*)(ws + WS_TOPW); int* RANK = (int*)(ws + WS_RANK);
    int* se = (int*)smem;
    const float* g = p->norm_ffn + DM; const float* rw = p->router_w;
    f32x4 wlo[4][4], whi[4][4];
#pragma unroll
    for (int j = 0; j < 4; ++j) { const f32x4 gv = *(const f32x4*)(g + 256 * j + 4 * lane);
#pragma unroll
        for (int q = 0; q < 4; ++q) { const float* w = rw + (size_t)(256 * j + 4 * lane + q) * NE; wlo[j][q] = *(const f32x4*)w * gv[q]; whi[j][q] = *(const f32x4*)(w + 4) * gv[q]; } }
    for (int grp = bid; grp < T / 64; grp += nb) {
        for (int i = 0; i < 8; ++i) {
            const int t = grp * 64 + wid * 8 + i; const bf16_t* xr = X + (size_t)t * DM;
            float acc[NE]; float ss = 0.f;
#pragma unroll
            for (int e = 0; e < NE; ++e) acc[e] = 0.f;
            u32x2 xw[4];
#pragma unroll
            for (int j = 0; j < 4; ++j) xw[j] = *(const u32x2*)(xr + 256 * j + 4 * lane);
#pragma unroll
            for (int j = 0; j < 4; ++j) { const f32x4 xv = {bf2f(xw[j].x & 0xffff), bf2f(xw[j].x >> 16), bf2f(xw[j].y & 0xffff), bf2f(xw[j].y >> 16)};
#pragma unroll
                for (int q = 0; q < 4; ++q) { const float xs = xv[q]; ss += xs * xs; const f32x4 w0 = wlo[j][q], w1 = whi[j][q];
                    acc[0] += xs * w0[0]; acc[1] += xs * w0[1]; acc[2] += xs * w0[2]; acc[3] += xs * w0[3]; acc[4] += xs * w1[0]; acc[5] += xs * w1[1]; acc[6] += xs * w1[2]; acc[7] += xs * w1[3]; } }
            ss = wave_sum(ss, lane);
#pragma unroll
            for (int e = 0; e < NE; ++e) acc[e] = wave_sum(acc[e], lane);
            const float rs = rsqrtf(ss * (1.0f / DM) + EPS);
            int e1 = 0; float l1 = acc[0];
#pragma unroll
            for (int e = 1; e < NE; ++e) if (acc[e] > l1) { l1 = acc[e]; e1 = e; }
            int e2 = -1; float l2 = -INFINITY;
#pragma unroll
            for (int e = 0; e < NE; ++e) if (e != e1 && acc[e] > l2) { l2 = acc[e]; e2 = e; }
            const float w2 = 1.f / (1.f + expf((l1 - l2) * rs)), w1 = 1.f - w2;
            if (lane == 0) { ((float*)(ws + WS_RSTOK))[t] = rs; TOPE[2 * t] = e1; TOPE[2 * t + 1] = e2; TOPW[2 * t] = w1; TOPW[2 * t + 1] = w2; se[2 * (wid * 8 + i)] = e1; se[2 * (wid * 8 + i) + 1] = e2; }
        }
        __syncthreads();
        if (wid == 0) {
            const int t = grp * 64 + lane, e1 = se[2 * lane], e2 = se[2 * lane + 1]; int r1 = 0, r2 = 0;
            for (int e = 0; e < NE; ++e) {
                const unsigned long long m1 = __ballot(e1 == e), m2 = __ballot(e2 == e);
                const int c1 = __popcll(m1), c2 = __popcll(m2);
                int base = 0; if (lane == 0 && (c1 + c2) > 0) base = atomicAdd(cnt + e, c1 + c2);
                base = __builtin_amdgcn_readfirstlane(base);
                const unsigned long long below = (lane == 0) ? 0ull : (~0ull >> (64 - lane));
                if (e1 == e) r1 = base + __popcll(m1 & below);
                if (e2 == e) r2 = base + c1 + __popcll(m2 & below);
            }
            RANK[2 * t] = r1; RANK[2 * t + 1] = r2;
        }
        __syncthreads();
    }
}
__device__ void gc_phase(PP p, int wv, int bid, int nb) {
    unsigned char* ws = p->ws; const int* cnt = (const int*)(ws + WS_CTL); int off[NE + 1]; expert_offsets(cnt, off);
    const int* TOPE = (const int*)(ws + WS_TOPE); const float* TOPW = (const float*)(ws + WS_TOPW); const int* RANK = (const int*)(ws + WS_RANK);
    int* rt = (int*)(ws + WS_ROWTOK); float* rw = (float*)(ws + WS_ROWW); int* rs = (int*)(ws + WS_ROWSLOT);
    for (int i = bid * NTHR + otid(wv); i < 2 * T; i += nb * NTHR) {
        const int e = TOPE[i]; int o = 0;
#pragma unroll
        for (int q = 0; q < NE; ++q) if (q == e) o = off[q];
        const int pos = o + RANK[i]; rt[pos] = i >> 1; rw[pos] = TOPW[i]; rs[pos] = i; ((float*)(ws + WS_ROWRS))[pos] = ((const float*)(ws + WS_RSTOK))[i >> 1];
    }
}
__device__ __forceinline__ void egu_phase(PP p, int wv, int bid, int nb, unsigned char* smem) {
    unsigned char* ws = p->ws; const int* cnt = (const int*)(ws + WS_CTL); int off[NE + 1]; expert_offsets(cnt, off);
    pg8::Gemm g{(const bf16_t*)(ws + WS_XB8), (const bf16_t*)(ws + WS_EGU), DM / 2, DM / 2, DM / 2, (const int*)(ws + WS_ROWTOK)};
    pg8::GroupedOrder S; S.so.init(off[NE] / 256, (2 * DFE) / 256, nb, bid); S.o1 = off[1]; S.o2 = off[2]; S.o3 = off[3]; S.o4 = off[4]; S.o5 = off[5]; S.o6 = off[6]; S.o7 = off[7];
    pg8::EpiW<EpiGU<true>> E{EpiGU<true>{(const float*)(ws + WS_ROWRS), nullptr, (bf16_t*)(ws + WS_ACT), DFE}, (2 * DFE) / 256};
    pg8::gemm_phase<pg8::EpiW<EpiGU<true>>, pg8::GroupedOrder, true, true, true>(wv, (PG8_LAS unsigned char*)smem, g, S, E);
}
__device__ __forceinline__ void ed_phase(PP p, int wv, int bid, int nb, unsigned char* smem) {
    unsigned char* ws = p->ws; const int* cnt = (const int*)(ws + WS_CTL); int off[NE + 1]; expert_offsets(cnt, off);
    pg8::Gemm g{(const bf16_t*)(ws + WS_ACT), (const bf16_t*)(ws + WS_ED), DFE / 2, DFE / 2, DFE / 2, nullptr};
    pg8::GroupedOrder S; S.so.init(off[NE] / 256, DM / 256, nb, bid); S.o1 = off[1]; S.o2 = off[2]; S.o3 = off[3]; S.o4 = off[4]; S.o5 = off[5]; S.o6 = off[6]; S.o7 = off[7];
    pg8::EpiW<EpiED> E{EpiED{(const float*)(ws + WS_ROWW), (const int*)(ws + WS_ROWSLOT), (bf16_t*)(ws + WS_Y)}, DM / 256};
    pg8::gemm_phase<pg8::EpiW<EpiED>, pg8::GroupedOrder, true, false, true>(wv, (PG8_LAS unsigned char*)smem, g, S, E);
}
__device__ void final_phase(PP p, int wv, int bid, int nb) {
    const int tid_ = otid(wv); const int lane = tid_ & 63, wid = tid_ >> 6; const bf16_t* Y = (const bf16_t*)(p->ws + WS_Y);
    for (int t = bid * NWAVE + wid; t < T; t += nb * NWAVE) {
        float* xr = p->out + (size_t)t * DM; const bf16_t* xb = (const bf16_t*)(p->ws + WS_XB) + (size_t)t * DM; f32x4 v[4]; u32x2 ya[4], yb[4]; float ss = 0.f;
#pragma unroll
        for (int j = 0; j < 4; ++j) { { const u32x2 xw = __builtin_nontemporal_load((const u32x2*)(xb + 256 * j + 4 * lane)); v[j] = (f32x4){bf2f(xw.x & 0xffff), bf2f(xw.x >> 16), bf2f(xw.y & 0xffff), bf2f(xw.y >> 16)}; }
            ya[j] = __builtin_nontemporal_load((const u32x2*)(Y + (size_t)(2 * t) * DM + 256 * j + 4 * lane)); yb[j] = __builtin_nontemporal_load((const u32x2*)(Y + (size_t)(2 * t + 1) * DM + 256 * j + 4 * lane)); }
#pragma unroll
        for (int j = 0; j < 4; ++j) { const u32x2 a = ya[j], b = yb[j];
            v[j][0] += bf2f(a.x & 0xffff) + bf2f(b.x & 0xffff); v[j][1] += bf2f(a.x >> 16) + bf2f(b.x >> 16); v[j][2] += bf2f(a.y & 0xffff) + bf2f(b.y & 0xffff); v[j][3] += bf2f(a.y >> 16) + bf2f(b.y >> 16);
            ss += (v[j][0] * v[j][0] + v[j][1] * v[j][1]) + (v[j][2] * v[j][2] + v[j][3] * v[j][3]); }
        ss = wave_sum(ss, lane); const float rs = __builtin_amdgcn_rsqf(ss * (1.0f / DM) + EPS);
#pragma unroll
        for (int j = 0; j < 4; ++j) { const f32x4 g = *(const f32x4*)(p->norm_final + 256 * j + 4 * lane); __builtin_nontemporal_store(v[j] * rs * g, (f32x4*)(xr + 256 * j + 4 * lane)); }
    }
}

enum { K_P0, K_GIN, K_LRUSUM, K_GQ, K_GKV, K_ATTN, K_LRUFIN, K_GOUT, K_FUP, K_FDOWN, K_ROUTER, K_GC, K_EGU, K_ED, K_FINAL };
template <int KIND>
__device__ __forceinline__ void run_kind(PP p, int wv, int l, int bid, int nb, unsigned char* smem) {
    unsigned char* ws = p->ws;
    if constexpr (KIND == K_P0) phase_p0(p, wv, bid, nb, smem);
    else if constexpr (KIND == K_GIN) {
        EpiIn E{(const float*)(ws + WS_SSX), (bf16_t*)(ws + WS_XL), (bf16_t*)(ws + WS_GY), (bf16_t*)(ws + WS_CQ), (bf16_t*)(ws + WS_KR), (float*)(ws + WS_SSQ), (float*)(ws + WS_SSKV), (const float*)(ws + WS_TAB)};
        gemm_static<EpiIn, true>(wv, (const bf16_t*)(ws + WS_XB), DM, (const bf16_t*)(ws + WS_WIN) + (size_t)l * INCP * DM, DM, T, INCP, DM, E, bid, nb, smem);
    } else if constexpr (KIND == K_LRUSUM) lru_sum_phase(p, wv, l, bid, nb, smem);
    else if constexpr (KIND == K_GQ) {
        EpiQ EQ{(const float*)(ws + WS_SSQ), (bf16_t*)(ws + WS_QF), (const float*)(ws + WS_TAB)};
        gemm_static<EpiQ, true>(wv, (const bf16_t*)(ws + WS_CQ), 384, (const bf16_t*)(ws + WS_WUQ) + (size_t)l * QW * QLORA, QLORA, T, QW, QLORA, EQ, bid, nb, smem);
    } else if constexpr (KIND == K_GKV) {
        EpiKV EK{(const float*)(ws + WS_SSKV), (bf16_t*)(ws + WS_KF), (bf16_t*)(ws + WS_VT)};
        gemm_static<EpiKV, true>(wv, (const bf16_t*)(ws + WS_CQ) + 128, 384, (const bf16_t*)(ws + WS_WUKV) + (size_t)l * KVW * 256, 256, T, KVW, 256, EK, bid, nb, smem);
    } else if constexpr (KIND == K_ATTN) attn_phase(p, wv, bid, nb, smem);
    else if constexpr (KIND == K_LRUFIN) lru_scan_phase(p, wv, bid, nb);
    else if constexpr (KIND == K_GOUT) {
        EpiRes E{(bf16_t*)(ws + WS_XB), l == 1 ? ws + WS_XB8 : nullptr, (float*)(ws + WS_SSX), 1.0f};
        gemm_static<EpiRes, true>(wv, (const bf16_t*)(ws + WS_MIX), DM, (const bf16_t*)(ws + WS_WOUT) + (size_t)l * DM * DM, DM, T, DM, DM, E, bid, nb, smem);
    } else if constexpr (KIND == K_FUP) {
        EpiGU<false> E{(const float*)(ws + WS_SSX), nullptr, (bf16_t*)(ws + WS_ACT), DFF};
        gemm_static<EpiGU<false>, true>(wv, (const bf16_t*)(ws + WS_XB), DM, (const bf16_t*)(ws + WS_WGU), DM, T, 2 * DFF, DM, E, bid, nb, smem);
    } else if constexpr (KIND == K_FDOWN) {
        EpiRes E{(bf16_t*)(ws + WS_XB), nullptr, (float*)(ws + WS_SSX), 1.0f};
        gemm_static<EpiRes, true>(wv, (const bf16_t*)(ws + WS_ACT), DFF, (const bf16_t*)(ws + WS_WD), DFF, T, DM, DFF, E, bid, nb, smem);
    } else if constexpr (KIND == K_ROUTER) router_phase(p, wv, bid, nb, smem);
    else if constexpr (KIND == K_GC) gc_phase(p, wv, bid, nb);
    else if constexpr (KIND == K_EGU) egu_phase(p, wv, bid, nb, smem);
    else if constexpr (KIND == K_ED) ed_phase(p, wv, bid, nb, smem);
    else final_phase(p, wv, bid, nb);
}

constexpr int LDS_BYTES = 163840;
template <int KIND>
__global__ void __launch_bounds__(NTHR) k_phase(P p, int l) {
    extern __shared__ __attribute__((aligned(16))) unsigned char smem[];
    run_kind<KIND>((PP)__builtin_amdgcn_kernarg_segment_ptr(), __builtin_amdgcn_readfirstlane((int)threadIdx.x >> 6), l, (int)blockIdx.x, (int)gridDim.x, smem);
}
template <int KIND> static void launch_kind(PP p, int l, int grid, hipStream_t stream) {
    static bool attr = false;
    if (!attr) { (void)hipFuncSetAttribute((const void*)k_phase<KIND>, hipFuncAttributeMaxDynamicSharedMemorySize, LDS_BYTES); attr = true; }
    hipLaunchKernelGGL(k_phase<KIND>, dim3(grid), dim3(NTHR), LDS_BYTES, stream, p, l);
}

#define XB_TMO      128
#define XB_XCNT(j)  (256  + 64 * (j))
#define XB_XSUB(j)  (1280 + 64 * (j))
#define XB_XGEN(j)  (2304 + 64 * (j))
#define XB_TOP      3328
#define XB_TOPGEN   3392
#define XCD_BAR_WORDS 3456
#define XB_SPIN_CAP (1u << 18)

__device__ __forceinline__ unsigned xb_ld(unsigned* p)              { return __hip_atomic_load(p, __ATOMIC_RELAXED, __HIP_MEMORY_SCOPE_AGENT); }
__device__ __forceinline__ unsigned xb_add(unsigned* p, unsigned v) { return __hip_atomic_fetch_add(p, v, __ATOMIC_RELAXED, __HIP_MEMORY_SCOPE_AGENT); }
__device__ __forceinline__ unsigned xb_xcc_id() { return (unsigned)__builtin_amdgcn_s_getreg((3 << 11) | 20) & 0xFu; }
#define XB_SPIN(cond, bar) do { unsigned _sp = 0; while (cond) { __builtin_amdgcn_s_sleep(1); \
    if ((++_sp & 255u) == 0u) { if (xb_ld(&(bar)[XB_TMO])) break; if (_sp > XB_SPIN_CAP) { atomicAdd(&(bar)[XB_TMO], 1u); break; } } } } while (0)

struct XcdBarrier {
    unsigned* bar; unsigned x;
    volatile LAS unsigned* st;
};

__device__ __forceinline__ XcdBarrier xcd_barrier_post(unsigned* bar, volatile LAS unsigned* st, bool leader) {
    XcdBarrier b; b.bar = bar; b.x = xb_xcc_id(); b.st = st;
    if (leader) (void)xb_add(&bar[XB_XCNT(b.x)], 1u);
    return b;
}
__device__ __forceinline__ void xcd_barrier_complete(unsigned* bar, unsigned x, unsigned& nloc, unsigned& nx) {
    const unsigned G = gridDim.x * gridDim.y * gridDim.z;
    unsigned sum, cnt, mine, sp = 0u;
    for (;;) {
        sum = 0u; cnt = 0u; mine = 0u;
#pragma unroll
        for (unsigned j = 0; j < 16; ++j) { const unsigned c = xb_ld(&bar[XB_XCNT(j)]); sum += c; cnt += (c > 0u) ? 1u : 0u; mine = (j == x) ? c : mine; }
        if (sum == G) break;
        __builtin_amdgcn_s_sleep(1);
        if ((++sp & 255u) == 0u) { if (xb_ld(&bar[XB_TMO])) break; if (sp > XB_SPIN_CAP) { atomicAdd(&bar[XB_TMO], 1u); break; } }
    }
    nloc = mine > 0u ? mine : 1u; nx = cnt > 0u ? cnt : 1u;
}

__device__ __forceinline__ void xcd_barrier(const XcdBarrier& b, bool leader) {
    asm volatile("s_waitcnt vmcnt(0)" ::: "memory");
    __syncthreads();
    if (leader) {
        unsigned* bar = b.bar;
        __builtin_amdgcn_s_waitcnt(0);
        unsigned nloc = b.st[0], nx = b.st[1];
        if (nloc == 0u) { xcd_barrier_complete(bar, b.x, nloc, nx); b.st[0] = nloc; b.st[1] = nx; }
        const unsigned old = xb_add(&bar[XB_XSUB(b.x)], 1u);
        const unsigned gen = old / nloc;
        if (old + 1u == (gen + 1u) * nloc) {
            __builtin_amdgcn_fence(__ATOMIC_RELEASE, "agent");
            asm volatile("s_waitcnt vmcnt(0)" ::: "memory");
            const unsigned og = xb_add(&bar[XB_TOP], 1u);
            const unsigned tg = og / nx;
            if (og + 1u == (tg + 1u) * nx) xb_add(&bar[XB_TOPGEN], 1u);
            else XB_SPIN(xb_ld(&bar[XB_TOPGEN]) == tg, bar);
            __builtin_amdgcn_fence(__ATOMIC_ACQUIRE, "agent");
            xb_add(&bar[XB_XGEN(b.x)], 1u);
            asm volatile("s_waitcnt vmcnt(0)" ::: "memory");
        } else {
            XB_SPIN(xb_ld(&bar[XB_XGEN(b.x)]) == gen, bar);
            __builtin_amdgcn_fence(__ATOMIC_ACQUIRE, "agent");
            asm volatile("s_waitcnt vmcnt(0)" ::: "memory");
        }
    }
    __syncthreads();
}


#if MK_MODE != 0
__global__ void __launch_bounds__(NTHR) mk_fused(P p_arg) {
    extern __shared__ __attribute__((aligned(16))) unsigned char smem[];
    const int bid0 = (int)blockIdx.x, nb0 = (int)gridDim.x;
    const PP kp = (PP)__builtin_amdgcn_kernarg_segment_ptr();
    const int wv = __builtin_amdgcn_readfirstlane((int)threadIdx.x >> 6);
    volatile LAS unsigned* misc = (volatile LAS unsigned*)((LAS unsigned char*)smem + MISC_OFF);
    if (threadIdx.x < 64) misc[threadIdx.x] = 0u;
    __syncthreads();
    (void)xcd_barrier_post((unsigned*)(kp->ws + WS_CTL) + CW_BAR, misc + 8, threadIdx.x == 0);
#define GRID_BAR() do { PP kq_ = kp; asm volatile("" : "+s"(kq_)); XcdBarrier b_; b_.bar = (unsigned*)(kq_->ws + WS_CTL) + CW_BAR; b_.x = xb_xcc_id(); b_.st = (volatile LAS unsigned*)((LAS unsigned char*)smem + MISC_OFF) + 8; \
        xcd_barrier(b_, otid(wv) == 0); } while (0)
#ifndef PROBE_DUP
#define PROBE_DUP -1
#endif
#define DUP(k, stmt) do { PP p = kp; int bid = bid0, nb = nb0; asm volatile("" : "+s"(p), "+s"(bid), "+s"(nb)); stmt; if (PROBE_DUP == (k)) { GRID_BAR(); stmt; } } while (0)
    DUP(0, run_kind<K_P0>(p, wv, 0, bid, nb, smem)); GRID_BAR();
#pragma unroll 1
    for (int l = 0; l < DEPTH; ++l) {
        DUP(1, run_kind<K_GIN>(p, wv, l, bid, nb, smem)); GRID_BAR();
        DUP(2, run_kind<K_LRUSUM>(p, wv, l, bid, nb, smem)); __syncthreads(); DUP(3, run_kind<K_GQ>(p, wv, l, bid, nb, smem)); __syncthreads(); DUP(4, run_kind<K_GKV>(p, wv, l, bid, nb, smem)); GRID_BAR();
        DUP(5, run_kind<K_ATTN>(p, wv, l, bid, nb, smem)); __syncthreads(); DUP(6, run_kind<K_LRUFIN>(p, wv, l, bid, nb, smem)); GRID_BAR();
        DUP(-2, run_kind<K_GOUT>(p, wv, l, bid, nb, smem)); GRID_BAR();
        if (l == 0) { DUP(7, run_kind<K_FUP>(p, wv, l, bid, nb, smem)); GRID_BAR(); DUP(-2, run_kind<K_FDOWN>(p, wv, l, bid, nb, smem)); GRID_BAR(); }
    }
    DUP(-2, run_kind<K_ROUTER>(p, wv, 1, bid, nb, smem)); GRID_BAR();
    DUP(8, run_kind<K_GC>(p, wv, 1, bid, nb, smem)); GRID_BAR();
    DUP(9, run_kind<K_EGU>(p, wv, 1, bid, nb, smem)); GRID_BAR();
    DUP(10, run_kind<K_ED>(p, wv, 1, bid, nb, smem)); GRID_BAR();
    DUP(-2, run_kind<K_FINAL>(p, wv, 1, bid, nb, smem));
#undef DUP
#undef GRID_BAR
}

#endif
extern "C" void kernel_launch(void* const* d_in, const int* in_sizes, int n_in, void* d_out, int out_size, void* d_ws, size_t ws_size, hipStream_t stream) {
    if (n_in != 25 || out_size != T * DM || ws_size < WS_END) { fprintf(stderr, "kernel_launch: unexpected shapes (n_in %d, out %d, ws %zu)\n", n_in, out_size, ws_size); return; }
    P p{};
    p.x = (const float*)d_in[0]; p.positions = (const int*)d_in[1]; p.norm_mix = (const float*)d_in[2]; p.w_in = (const float*)d_in[3]; p.conv_w = (const float*)d_in[4]; p.conv_b = (const float*)d_in[5];
    p.lru_wa = (const float*)d_in[6]; p.lru_ba = (const float*)d_in[7]; p.lru_wx = (const float*)d_in[8]; p.lru_bx = (const float*)d_in[9]; p.lru_lambda = (const float*)d_in[10]; p.q_norm = (const float*)d_in[11];
    p.w_uq = (const float*)d_in[12]; p.kv_norm = (const float*)d_in[13]; p.w_ukv = (const float*)d_in[14]; p.w_out = (const float*)d_in[15]; p.norm_ffn = (const float*)d_in[16];
    p.dense_w_gate = (const float*)d_in[17]; p.dense_w_up = (const float*)d_in[18]; p.dense_w_down = (const float*)d_in[19]; p.router_w = (const float*)d_in[20];
    p.expert_w_gate = (const float*)d_in[21]; p.expert_w_up = (const float*)d_in[22]; p.expert_w_down = (const float*)d_in[23]; p.norm_final = (const float*)d_in[24];
    p.out = (float*)d_out; p.ws = (unsigned char*)d_ws;
#if MK_MODE == 0
    const int G = 1024;
    launch_kind<K_P0>(p, 0, G, stream);
    for (int l = 0; l < DEPTH; ++l) {
        launch_kind<K_GIN>(p, l, G, stream);
        launch_kind<K_LRUSUM>(p, l, 256, stream); launch_kind<K_GQ>(p, l, G, stream); launch_kind<K_GKV>(p, l, G, stream);
        launch_kind<K_ATTN>(p, l, G, stream); launch_kind<K_LRUFIN>(p, l, 256, stream);
        launch_kind<K_GOUT>(p, l, G, stream);
        if (l == 0) { launch_kind<K_FUP>(p, l, G, stream); launch_kind<K_FDOWN>(p, l, G, stream); }
        else { launch_kind<K_ROUTER>(p, l, 256, stream); launch_kind<K_GC>(p, l, 64, stream); launch_kind<K_EGU>(p, l, G, stream); launch_kind<K_ED>(p, l, G, stream); launch_kind<K_FINAL>(p, l, G, stream); }
    }
#else
    static int grid_blocks = 0;
    if (!grid_blocks) {
        int dev = 0, cus = 0, per_cu = 0;
        (void)hipGetDevice(&dev); (void)hipDeviceGetAttribute(&cus, hipDeviceAttributeMultiprocessorCount, dev);
        (void)hipFuncSetAttribute((const void*)mk_fused, hipFuncAttributeMaxDynamicSharedMemorySize, LDS_BYTES);
        (void)hipOccupancyMaxActiveBlocksPerMultiprocessor(&per_cu, (const void*)mk_fused, NTHR, LDS_BYTES);
        if (per_cu < 1) { fprintf(stderr, "kernel_launch: occupancy query says %d blocks/CU\n", per_cu); per_cu = 1; }
        grid_blocks = cus * 1;
    }
    (void)hipMemsetAsync((char*)d_ws + WS_CTL, 0, CTL_ZERO_BYTES, stream);
    void* args[] = {&p};
    hipError_t e = hipLaunchCooperativeKernel((const void*)mk_fused, dim3(grid_blocks), dim3(NTHR), args, LDS_BYTES, stream);
    if (e != hipSuccess) fprintf(stderr, "cooperative launch failed: %s (grid %d)\n", hipGetErrorString(e), grid_blocks);
#endif
}
```

```cpp
#include <hip/hip_runtime.h>
#include <hip/hip_cooperative_groups.h>
#include <cstdint>
#include <cstdio>
namespace cg = cooperative_groups;
#ifndef MK_MODE
#define MK_MODE 1
#endif

#define LAS __attribute__((address_space(3)))
typedef unsigned short bf16_t;
typedef short bf16x8 __attribute__((ext_vector_type(8)));
typedef float f32x4 __attribute__((ext_vector_type(4)));
typedef float f32x16 __attribute__((ext_vector_type(16)));
typedef unsigned u32x4 __attribute__((ext_vector_type(4)));
typedef unsigned u32x2 __attribute__((ext_vector_type(2)));
typedef float f32x2_t __attribute__((ext_vector_type(2)));

constexpr int BATCH = 4, SEQ = 4096, T = BATCH * SEQ, DM = 1024, DEPTH = 2;
constexpr int LRU_W = 512, NH = 8, QKN = 64, QKR = 32, VH = 64, QLORA = 256, KVLORA = 128;
constexpr int INC = 1440, INCP = 1536, DQK = QKN + QKR  , QW = NH * DQK  , KVW = NH * (QKN + VH)  ;
constexpr int DFF = 2816, NE = 8, DFE = 1792;
constexpr float EPS = 1e-6f;
constexpr int NTHR = 512, NWAVE = 8;
constexpr int ROWS_MAX = 2 * T + NE * 256;
constexpr float QSCALE = 0.10206207261596577f * 1.4426950408889634f;

constexpr size_t MiB = 1u << 20;
constexpr size_t WS_CTL = 0;
constexpr size_t WS_TAB = 1 * MiB;
constexpr size_t WS_SSX = 3 * MiB;
constexpr size_t WS_SSQ = 5 * MiB;
constexpr size_t WS_SSKV = 5 * MiB + 512 * 1024;
constexpr size_t WS_SUM = 6 * MiB;
constexpr size_t WS_TOPE = 7 * MiB;
constexpr size_t WS_TOPW = WS_TOPE + 128 * 1024;
constexpr size_t WS_RANK = WS_TOPW + 128 * 1024;
constexpr size_t WS_ROWTOK = WS_RANK + 128 * 1024;
constexpr size_t WS_ROWW = WS_ROWTOK + 136 * 1024;
constexpr size_t WS_ROWSLOT = WS_ROWW + 136 * 1024;
constexpr size_t WS_RSTOK = WS_ROWSLOT + 136 * 1024;
constexpr size_t WS_ROWRS = WS_RSTOK + 64 * 1024;
constexpr size_t WS_LW = 5 * MiB + 768 * 1024;
constexpr size_t WS_WIN = 8 * MiB;
constexpr size_t WS_WUQ = 14 * MiB;
constexpr size_t WS_WUKV = 15 * MiB;
constexpr size_t WS_WOUT = 16 * MiB;
constexpr size_t WS_WGU = 20 * MiB;
constexpr size_t WS_WD = 31 * MiB;
constexpr size_t WS_XB = 37 * MiB;
constexpr size_t WS_EGU = 84 * MiB;
constexpr size_t WS_ED = 69 * MiB;
constexpr size_t WS_LAU = 116 * MiB;
constexpr size_t WS_Y = 84 * MiB;
constexpr size_t WS_XB8 = 216 * MiB;
constexpr size_t WS_ACT = 153 * MiB;
constexpr size_t WS_XL = 153 * MiB, WS_GY = 169 * MiB, WS_QF = 185 * MiB, WS_KF = 209 * MiB, WS_VT = 233 * MiB;
constexpr size_t WS_CQ = 249 * MiB  , WS_KR = 225 * MiB  , WS_MIX = 249 * MiB;
constexpr size_t WS_END = 281 * MiB;

constexpr int MISC_OFF = 163840 - 256;
constexpr int CW_BAR = 4096;
constexpr size_t CTL_ZERO_BYTES = 65536;
struct P {
    const float *x; const int* positions; const float *norm_mix, *w_in, *conv_w, *conv_b, *lru_wa, *lru_ba, *lru_wx, *lru_bx, *lru_lambda, *q_norm, *w_uq, *kv_norm, *w_ukv,
        *w_out, *norm_ffn, *dense_w_gate, *dense_w_up, *dense_w_down, *router_w, *expert_w_gate, *expert_w_up, *expert_w_down, *norm_final;
    float* out; unsigned char* ws;
};
typedef const __attribute__((address_space(4))) P* PP;

__device__ __forceinline__ int otid(int wv) { int t = (wv << 6) | (int)__builtin_amdgcn_mbcnt_hi(~0u, __builtin_amdgcn_mbcnt_lo(~0u, 0u)); asm volatile("" : "+v"(t)); return t; }
typedef __bf16 bf16x2_t __attribute__((ext_vector_type(2)));
__device__ __forceinline__ unsigned pk2(float lo, float hi) { f32x2_t v = {lo, hi}; bf16x2_t b = __builtin_convertvector(v, bf16x2_t); return __builtin_bit_cast(unsigned, b); }
__device__ __forceinline__ unsigned f2bf(float f) { return pk2(f, 0.f) & 0xffffu; }
__device__ __forceinline__ float bf2f(unsigned short b) { return __builtin_bit_cast(float, (unsigned)b << 16); }
constexpr float F8_WS = 256.f, F8_XS = 8.f, F8_AS = 16.f;
__device__ __forceinline__ unsigned pk4_fp8(float a, float b, float c, float d) {
    a = fminf(fmaxf(a, -448.f), 448.f); b = fminf(fmaxf(b, -448.f), 448.f); c = fminf(fmaxf(c, -448.f), 448.f); d = fminf(fmaxf(d, -448.f), 448.f);
    unsigned w = 0u; w = __builtin_amdgcn_cvt_pk_fp8_f32(a, b, w, false); w = __builtin_amdgcn_cvt_pk_fp8_f32(c, d, w, true); return w; }
__device__ __forceinline__ void store4bf(bf16_t* p, f32x4 v) { u32x2 w; w.x = pk2(v[0], v[1]); w.y = pk2(v[2], v[3]); *(u32x2*)p = w; }
__device__ __forceinline__ void store8bf_x(bf16_t* p, int col, f32x4 v0, f32x4 v1) {
    const auto rx = __builtin_amdgcn_permlane16_swap(pk2(v0[0], v0[1]), pk2(v1[0], v1[1]), false, false), ry = __builtin_amdgcn_permlane16_swap(pk2(v0[2], v0[3]), pk2(v1[2], v1[3]), false, false);
    *(u32x4*)((col & 4) ? p + 12 : p) = (u32x4){rx[0], ry[0], rx[1], ry[1]};
}
__device__ __forceinline__ void store4bf_x(bf16_t* p, int col, f32x4 v) {
    const unsigned ax = pk2(v[0], v[1]), ay = pk2(v[2], v[3]);
    const auto rx = __builtin_amdgcn_permlane16_swap(ax, ax, false, false), ry = __builtin_amdgcn_permlane16_swap(ay, ay, false, false);
    if (!(col & 4)) *(u32x4*)p = (u32x4){rx[0], ry[0], rx[1], ry[1]};
}
__device__ __forceinline__ float sigmoidf_(float x) { return __builtin_amdgcn_rcpf(1.f + __builtin_amdgcn_exp2f(-1.4426950408889634f * x)); }
__device__ __forceinline__ float gelu_tanh(float x) { const float u = 0.7978845608028654f * (x + 0.044715f * x * x * x); return x * sigmoidf_(2.0f * u); }
__device__ __forceinline__ float fq_sum(float s) {
    { const auto r = __builtin_amdgcn_permlane16_swap(__float_as_uint(s), __float_as_uint(s), false, false); s = __uint_as_float(r[0]) + __uint_as_float(r[1]); }
    { const auto r = __builtin_amdgcn_permlane32_swap(__float_as_uint(s), __float_as_uint(s), false, false); s = __uint_as_float(r[0]) + __uint_as_float(r[1]); }
    return s; }
__device__ __forceinline__ float shfl_xor_l(float v, int lane, int mask) { return __builtin_bit_cast(float, __builtin_amdgcn_ds_bpermute((lane ^ mask) << 2, __builtin_bit_cast(int, v))); }
__device__ __forceinline__ float wave_sum(float v, int lane) {
#pragma unroll
    for (int o = 1; o < 64; o <<= 1) v += shfl_xor_l(v, lane, o);
    return v;
}
__device__ __forceinline__ float row_rs(const float* ss, int row, int nslot, float inv_n) {
    float s = 0.f;
    for (int i = 0; i < nslot; i += 4) { const f32x4 v = *(const f32x4*)(ss + (size_t)row * nslot + i); s += (v[0] + v[1]) + (v[2] + v[3]); }
    return rsqrtf(s * inv_n + EPS);
}

constexpr int NMAT = 4 * DEPTH + 2 * 8 * DEPTH + 3 + 3 * NE;
struct MatDesc { const float* src; bf16_t* dst; const float* gain; int K, N, ldk, koff, mode, start, f8; };
__device__ __forceinline__ void get_mat(PP p, int m, MatDesc& d) {
    unsigned char* ws = p->ws; d.gain = nullptr; d.mode = 0; d.koff = 0; d.start = 0; d.f8 = 0;
    if (m < 4 * DEPTH) { const int l = m >> 2, w = m & 3;
        if (w == 0) { d.src = p->w_in + (size_t)l * DM * INC; d.K = DM; d.N = INC; d.dst = (bf16_t*)(ws + WS_WIN) + (size_t)l * INCP * DM; d.gain = p->norm_mix + l * DM; d.ldk = DM; }
        else if (w == 1) { d.src = p->w_uq + (size_t)l * QLORA * QW; d.K = QLORA; d.N = QW; d.dst = (bf16_t*)(ws + WS_WUQ) + (size_t)l * QW * QLORA; d.gain = p->q_norm + l * QLORA; d.ldk = QLORA; }
        else if (w == 2) { d.src = p->w_ukv + (size_t)l * KVLORA * KVW; d.K = KVLORA; d.N = KVW; d.dst = (bf16_t*)(ws + WS_WUKV) + (size_t)l * KVW * 256; d.gain = p->kv_norm + l * KVLORA; d.ldk = 256; d.koff = 128; }
        else { d.src = p->w_out + (size_t)l * DM * DM; d.K = DM; d.N = DM; d.dst = (bf16_t*)(ws + WS_WOUT) + (size_t)l * DM * DM; d.ldk = DM; }
        return; }
    m -= 4 * DEPTH;
    if (m < 2 * 8 * DEPTH) { const int q = m >> 1, w = m & 1; d.src = (w ? p->lru_wx : p->lru_wa) + (size_t)q * 4096; d.K = 64; d.N = 64; d.dst = (bf16_t*)(ws + WS_LW) + (size_t)(q * 2 + w) * 4096; d.ldk = 64; return; }
    m -= 2 * 8 * DEPTH;
    if (m < 3) {
        if (m == 0) { d.src = p->dense_w_gate; d.K = DM; d.N = DFF; d.dst = (bf16_t*)(ws + WS_WGU); d.gain = p->norm_ffn; d.ldk = DM; d.mode = 1; }
        else if (m == 1) { d.src = p->dense_w_up; d.K = DM; d.N = DFF; d.dst = (bf16_t*)(ws + WS_WGU); d.gain = p->norm_ffn; d.ldk = DM; d.mode = 2; }
        else { d.src = p->dense_w_down; d.K = DFF; d.N = DM; d.dst = (bf16_t*)(ws + WS_WD); d.ldk = DFF; d.f8 = 1; }
        return; }
    m -= 3;
    { const int e = m / 3, w = m % 3;
      d.f8 = 1;
      if (w == 0) { d.src = p->expert_w_gate + (size_t)e * DM * DFE; d.K = DM; d.N = DFE; d.dst = (bf16_t*)(ws + WS_EGU + (size_t)e * 2 * DFE * DM); d.gain = p->norm_ffn + DM; d.ldk = DM; d.mode = 1; }
      else if (w == 1) { d.src = p->expert_w_up + (size_t)e * DM * DFE; d.K = DM; d.N = DFE; d.dst = (bf16_t*)(ws + WS_EGU + (size_t)e * 2 * DFE * DM); d.gain = p->norm_ffn + DM; d.ldk = DM; d.mode = 2; }
      else { d.src = p->expert_w_down + (size_t)e * DFE * DM; d.K = DFE; d.N = DM; d.dst = (bf16_t*)(ws + WS_ED + (size_t)e * DM * DFE); d.ldk = DFE; } }
}

__device__ void phase_p0(PP p, int wv, int bid, int nb, unsigned char* smem) {
    const int tid = otid(wv), lane = tid & 63, wid = tid >> 6;
    const int gw = bid * NWAVE + wid, ngw = nb * NWAVE;
    unsigned char* ws = p->ws;
    MatDesc* tabm = (MatDesc*)smem;
    if (tid < NMAT) { MatDesc d; get_mat(p, tid, d); const int ksh = d.f8 ? 2 : 1; d.start = (d.K >> (5 + ksh)) * ((d.N + (256 >> ksh) - 1) / (256 >> ksh)); tabm[tid] = d; }
    __syncthreads();
    if (tid == 0) { int acc = 0; for (int m = 0; m < NMAT; ++m) { const int n = tabm[m].start; tabm[m].start = acc; acc += n; } ((int*)(tabm + NMAT))[0] = acc; }
    __syncthreads();
    const int total = ((const int*)(tabm + NMAT))[0];
    for (int item = gw; item < total; item += ngw) {
        int lo = 0, hi = NMAT - 1;
        while (lo < hi) { const int mid = (lo + hi + 1) >> 1; if (tabm[mid].start <= item) lo = mid; else hi = mid - 1; }
        const MatDesc d = tabm[lo];
        const int ksh = d.f8 ? 2 : 1, nw = 256 >> ksh, local = item - d.start, nbn = (d.N + nw - 1) / nw, kb = local / nbn, nbk = local % nbn, k0 = (32 << ksh) * kb + 32 * (lane & ((1 << ksh) - 1)), n0 = nw * nbk + 4 * (lane >> ksh);
        if (n0 < d.N) {
            f32x4 v[32];
#pragma unroll
            for (int j = 0; j < 32; ++j) v[j] = __builtin_nontemporal_load((const f32x4*)(d.src + (size_t)(k0 + j) * d.N + n0));
            if (d.gain) {
#pragma unroll
                for (int j = 0; j < 32; ++j) v[j] *= d.gain[k0 + j];
            }
#pragma unroll
            for (int e = 0; e < 4; ++e) { const int n = n0 + e; const int drow = d.mode == 0 ? n : ((n >> 4) * 32 + (n & 15) + (d.mode == 2 ? 16 : 0));
                if (d.f8) { unsigned char* dp8 = (unsigned char*)d.dst + (size_t)drow * d.ldk + k0;
#pragma unroll
                    for (int q = 0; q < 2; ++q) { u32x4 o;
#pragma unroll
                        for (int r = 0; r < 4; ++r) o[r] = pk4_fp8(v[16 * q + 4 * r][e] * F8_WS, v[16 * q + 4 * r + 1][e] * F8_WS, v[16 * q + 4 * r + 2][e] * F8_WS, v[16 * q + 4 * r + 3][e] * F8_WS);
                        *(u32x4*)(dp8 + 16 * q) = o; } }
                else { bf16_t* dp = d.dst + (size_t)drow * d.ldk + d.koff + k0;
#pragma unroll
                for (int q = 0; q < 4; ++q) { u32x4 o; o.x = pk2(v[8 * q][e], v[8 * q + 1][e]); o.y = pk2(v[8 * q + 2][e], v[8 * q + 3][e]); o.z = pk2(v[8 * q + 4][e], v[8 * q + 5][e]); o.w = pk2(v[8 * q + 6][e], v[8 * q + 7][e]);
                    *(u32x4*)(dp + 8 * q) = o; } } }
        }
    }
    const int gt = bid * NTHR + tid, ngt = nb * NTHR;
    for (int l = 0; l < DEPTH; ++l) { u32x4* z = (u32x4*)((bf16_t*)(ws + WS_WIN) + ((size_t)l * INCP + INC) * DM); for (int i = gt; i < (INCP - INC) * DM / 8; i += ngt) z[i] = (u32x4){0u, 0u, 0u, 0u}; }
    for (int l = 0; l < DEPTH; ++l) { bf16_t* wk = (bf16_t*)(ws + WS_WUKV) + (size_t)l * KVW * 256; for (int i = gt; i < KVW * 16; i += ngt) *(u32x4*)(wk + (size_t)(i >> 4) * 256 + (i & 15) * 8) = (u32x4){0u, 0u, 0u, 0u}; }
    { float* tab = (float*)(ws + WS_TAB);
      for (int i = gt; i < T * 16; i += ngt) { const int t = i >> 4, f = i & 15; const float inv = 1.0f / powf(10000.0f, (float)f / 16.0f); const float ang = (float)p->positions[t] * inv;
          float s, c; sincosf(ang, &s, &c); tab[2 * i] = c; tab[2 * i + 1] = s; } }
    { int* cnt = (int*)(ws + WS_CTL); if (gt < 64) cnt[gt] = 0;
      int* rt = (int*)(ws + WS_ROWTOK); float* rw = (float*)(ws + WS_ROWW); int* rs = (int*)(ws + WS_ROWSLOT); float* rrs = (float*)(ws + WS_ROWRS);
      for (int i = gt; i < ROWS_MAX; i += ngt) { rt[i] = 0; rw[i] = 0.f; rs[i] = -1; rrs[i] = 0.f; } }
    { bf16_t* XB = (bf16_t*)(ws + WS_XB); float* ssx = (float*)(ws + WS_SSX);
      for (int r = 2 * gw; r < T; r += 2 * ngw) {
          const f32x4* xr = (const f32x4*)(p->x + (size_t)r * DM) + lane; f32x4 v[8];
#pragma unroll
          for (int j = 0; j < 8; ++j) v[j] = __builtin_nontemporal_load(xr + 64 * j);
#pragma unroll
          for (int j = 0; j < 8; ++j) { const int rr = r + (j >> 2), jj = j & 3; store4bf(XB + (size_t)rr * DM + 256 * jj + 4 * lane, v[j]);
              float s = (v[j][0] * v[j][0] + v[j][1] * v[j][1]) + (v[j][2] * v[j][2] + v[j][3] * v[j][3]); s += shfl_xor_l(s, lane, 1); s += shfl_xor_l(s, lane, 2); s += shfl_xor_l(s, lane, 4);
              if ((lane & 7) == 0) ssx[(size_t)rr * 32 + 8 * jj + (lane >> 3)] = s; } } }
}

namespace pg8 {
#define PG8_LAS __attribute__((address_space(3)))
constexpr int BM = 256, BK = 64, HALF = 128, HTB = HALF * BK * 2, STAGE_BYTES = 8 * HTB, NXCD = 8, WGM = 8;
__host__ __device__ __forceinline__ int lds_byte(int r, int c) { const int st = (r >> 4) * 2 + (c >> 5), rr = r & 15, cc = c & 31, ob = rr * 64 + cc * 2; return st * 1024 + (ob ^ (((ob >> 9) & 1) << 5)); }
__host__ __device__ __forceinline__ void stage_rc(int b, int& R, int& C) { const int st = b / 1024, sb = b % 1024, swz = sb ^ (((sb >> 9) & 1) << 5); R = (st >> 1) * 16 + swz / 64; C = (st & 1) * 32 + (swz % 64) / 2; }
typedef int v8i_t __attribute__((ext_vector_type(8))); typedef int v4i_t __attribute__((ext_vector_type(4)));
__device__ __forceinline__ v8i_t cat8(bf16x8 a, bf16x8 b) { const v4i_t x = __builtin_bit_cast(v4i_t, a), y = __builtin_bit_cast(v4i_t, b); return __builtin_shufflevector(x, y, 0, 1, 2, 3, 4, 5, 6, 7); }
struct Unit { int pm, pn, hf; };
struct Gemm { const bf16_t* A; const bf16_t* Bt; int lda, ldb, K; const int* rowidx; };
struct StaticOrder {
    int nM, nN, nwg, G, c, full, tail2;
    __device__ __forceinline__ void init(int nM_, int nN_, int G_, int c_) { nM = nM_; nN = nN_; nwg = nM * nN; G = G_; c = c_; full = (nwg / G) * G; const int R = nwg - full; tail2 = (R > 0 && 2 * R <= G) ? 2 * R : 0; }
    __device__ __forceinline__ bool next(int i, Unit& u) const {
        if (tail2 && c < tail2 && (c & 1)) { const int rt = full / G; if (i > rt) return false; i = (i == 0) ? rt : i - 1; }
        const long L = (long)i * G + c; int wgid; u.hf = -1;
        if (tail2 && L >= full) { const int t = (int)(L - full); if (t >= tail2) return false; wgid = full + (t >> 1); u.hf = t & 1; }
        else { if (L >= nwg) return false; wgid = (int)L; }
        { const int q = nwg / NXCD, r = nwg % NXCD, xcd = wgid % NXCD, off = wgid / NXCD; wgid = (xcd < r ? xcd * (q + 1) : r * (q + 1) + (xcd - r) * q) + off; }
        const int nig = WGM * nN, gid = wgid / nig, fm = gid * WGM, gsz = (nM - fm) < WGM ? (nM - fm) : WGM;
        u.pm = fm + ((wgid % nig) % gsz); u.pn = (wgid % nig) / gsz; return true;
    }
};
struct GroupedOrder {
    StaticOrder so; int o1, o2, o3, o4, o5, o6, o7;
    __device__ __forceinline__ bool next(int i, Unit& u) const {
        if (!so.next(i, u)) return false;
        const int r0 = u.pm * BM; const int e = (r0 >= o1) + (r0 >= o2) + (r0 >= o3) + (r0 >= o4) + (r0 >= o5) + (r0 >= o6) + (r0 >= o7);
        u.pn += e * so.nN; return true;
    }
};
template <class Epi, class Sched, bool ALIGN_EPI, bool GATHER, bool FP8 = false>
__device__ __forceinline__ void gemm_phase(int wv, PG8_LAS unsigned char* lds, const Gemm g, const Sched& S, const Epi& E) {
    const int tid = otid(wv), wid = __builtin_amdgcn_readfirstlane(tid >> 6), lane = tid & 63, wr = wid >> 2, wc = wid & 3, fr = lane & 15, fq = lane >> 4;
    const int K = g.K, nt = K / BK;
    int Rr[2]; unsigned cA2[2]; unsigned voffA[2][2], nvoffA[2][2], voffB[2];
#pragma unroll
    for (int i = 0; i < 2; ++i) { int R, C; stage_rc(tid * 16 + i * 8192, R, C); Rr[i] = R; cA2[i] = (unsigned)C * 2u;
        voffA[0][i] = (unsigned)(R * g.lda + C) * 2u; voffA[1][i] = (unsigned)((R + HALF) * g.lda + C) * 2u; voffB[i] = (unsigned)(R * g.ldb + C) * 2u;
        nvoffA[0][i] = voffA[0][i]; nvoffA[1][i] = voffA[1][i]; }
    const size_t kstep = (size_t)(BK * 2);
    const size_t hstepB = (size_t)HALF * g.ldb * 2, tstepB = 2 * hstepB, tstepA = (size_t)BM * g.lda * 2;
    const unsigned ldsw = (unsigned)wid * 1024u;
    const int aoff = lds_byte(wr * 64 + fr, fq * 8), boff = lds_byte(wc * 32 + fr, fq * 8);
#define PG8_SA(b, h) (((b) * 2 + (h)) * HTB)
#define PG8_SB(b, h) ((4 + (b) * 2 + (h)) * HTB)
#define PG8_STAGE(bufoff, gbase, voff) do { _Pragma("unroll") for (int _i = 0; _i < 2; ++_i) \
        __builtin_amdgcn_global_load_lds((const unsigned*)((const char*)(gbase) + (voff)[_i]), (PG8_LAS unsigned*)(lds + (bufoff) + ldsw + _i * 8192), 16, 0, 0); } while (0)
#define PG8_STAGE_SEL(bufoff, gbase, sel, vn, vc) do { _Pragma("unroll") for (int _i = 0; _i < 2; ++_i) \
        __builtin_amdgcn_global_load_lds((const unsigned*)((const char*)(gbase) + ((sel) ? (vn)[_i] : (vc)[_i])), (PG8_LAS unsigned*)(lds + (bufoff) + ldsw + _i * 8192), 16, 0, 0); } while (0)
#define PG8_LDA(dst, b, h) do { _Pragma("unroll") for (int m = 0; m < 4; ++m) { \
        if constexpr (FP8) dst##8[m] = cat8(*(const PG8_LAS bf16x8*)(lds + PG8_SA(b, h) + aoff + m * 2048), *(const PG8_LAS bf16x8*)(lds + PG8_SA(b, h) + aoff + m * 2048 + 1024)); \
        else { _Pragma("unroll") for (int k = 0; k < 2; ++k) dst[m][k] = *(const PG8_LAS bf16x8*)(lds + PG8_SA(b, h) + aoff + m * 2048 + k * 1024); } } } while (0)
#define PG8_LDB(dst, b, h) do { _Pragma("unroll") for (int n = 0; n < 2; ++n) { \
        if constexpr (FP8) dst##8[n] = cat8(*(const PG8_LAS bf16x8*)(lds + PG8_SB(b, h) + boff + n * 2048), *(const PG8_LAS bf16x8*)(lds + PG8_SB(b, h) + boff + n * 2048 + 1024)); \
        else { _Pragma("unroll") for (int k = 0; k < 2; ++k) dst[n][k] = *(const PG8_LAS bf16x8*)(lds + PG8_SB(b, h) + boff + n * 2048 + k * 1024); } } } while (0)
#define PG8_MMA(ai, bj, At, Bt) do { __builtin_amdgcn_s_setprio(1); _Pragma("unroll") for (int m = 0; m < 4; ++m) _Pragma("unroll") for (int n = 0; n < 2; ++n) { \
        if constexpr (FP8) asm volatile("v_mfma_scale_f32_16x16x128_f8f6f4 %0, %1, %2, %0, %3, %3 op_sel_hi:[0,0,0]" : "+v"(acc[ai][bj][m][n]) : "v"(Bt##8[n]), "v"(At##8[m]), "v"(one_scale));     \
        else { _Pragma("unroll") for (int k = 0; k < 2; ++k) acc[ai][bj][m][n] = __builtin_amdgcn_mfma_f32_16x16x32_bf16(Bt[n][k], At[m][k], acc[ai][bj][m][n], 0, 0, 0); } } __builtin_amdgcn_s_setprio(0); } while (0)
#define PG8_WAIT_V(n) asm volatile("s_waitcnt vmcnt(" #n ")" ::: "memory")
#define PG8_WAIT_L(n) asm volatile("s_waitcnt lgkmcnt(" #n ")" ::: "memory")
#define PG8_BAR __builtin_amdgcn_s_barrier()
#define PG8_SCHED __builtin_amdgcn_sched_barrier(0)
#define PG8_GATHER_OFF(dst, u_) do { _Pragma("unroll") for (int _h = 0; _h < 2; ++_h) _Pragma("unroll") for (int _i = 0; _i < 2; ++_i) \
        dst[_h][_i] = (unsigned)g.rowidx[(u_).pm * BM + ((u_).hf < 0 ? _h : (u_).hf) * HALF + Rr[_i]] * (unsigned)(g.lda * 2) + cA2[_i]; } while (0)
    Unit cur, nxt; int ui = 0;
    if (!S.next(0, cur)) return;
    f32x4 acc[2][2][4][2];
#pragma unroll
    for (int a = 0; a < 2; ++a)
#pragma unroll
        for (int b = 0; b < 2; ++b)
#pragma unroll
            for (int m = 0; m < 4; ++m)
#pragma unroll
                for (int n = 0; n < 2; ++n) { acc[a][b][m][n] = (f32x4){0.f, 0.f, 0.f, 0.f}; if constexpr (FP8) asm volatile("" : "+v"(acc[a][b][m][n])); }
    const int one_scale = 0x7f7f7f7f;
    bf16x8 At[4][2], B0[2][2], B1[2][2]; v8i_t At8[4], B08[2], B18[2];
    if constexpr (GATHER) { PG8_GATHER_OFF(voffA, cur); }
    const size_t hstepA = (size_t)HALF * g.lda * 2;
    if (cur.hf >= 0) { voffA[1][0] = 0u; voffA[1][1] = 0u; }
    const char* cA = (const char*)g.A + (GATHER ? (size_t)0 : (size_t)cur.pm * tstepA + (cur.hf > 0 ? hstepA : (size_t)0)); const char* cB = (const char*)g.Bt + (size_t)cur.pn * tstepB;
    PG8_STAGE(PG8_SB(0, 0), cB, voffB); PG8_STAGE(PG8_SB(0, 1), cB + hstepB, voffB); PG8_STAGE(PG8_SA(0, 0), cA, voffA[0]); PG8_STAGE(PG8_SA(0, 1), cA, voffA[1]);
    if (wr == 1) PG8_BAR;
    PG8_WAIT_V(2); PG8_BAR;
    PG8_STAGE(PG8_SB(1, 0), cB + kstep, voffB); PG8_STAGE(PG8_SA(1, 0), cA + kstep, voffA[0]); PG8_STAGE(PG8_SB(1, 1), cB + hstepB + kstep, voffB);
    PG8_WAIT_V(6); PG8_BAR;
    for (;;) {
        const bool has_next = S.next(ui + 1, nxt);
        if constexpr (!GATHER) { const bool nh = has_next ? (nxt.hf >= 0) : (cur.hf >= 0); const unsigned hs = (unsigned)(HALF * g.lda * 2);
            nvoffA[1][0] = nh ? 0u : voffA[0][0] + hs; nvoffA[1][1] = nh ? 0u : voffA[0][1] + hs; }
        if constexpr (GATHER) { if (has_next) { PG8_GATHER_OFF(nvoffA, nxt); } else {
#pragma unroll
            for (int h = 0; h < 2; ++h)
#pragma unroll
                for (int i = 0; i < 2; ++i) nvoffA[h][i] = voffA[h][i]; } }
        const char* nA = GATHER ? (const char*)g.A : (has_next ? (const char*)g.A + (size_t)nxt.pm * tstepA + (nxt.hf > 0 ? hstepA : (size_t)0) : cA); const char* nB = has_next ? (const char*)g.Bt + (size_t)nxt.pn * tstepB : cB;
#pragma unroll 1
        for (int t = 0; t < nt; t += 2) {
            const bool last = (t == nt - 2);
            const char* a1 = cA + (size_t)(t + 1) * kstep;
            const char* a2 = last ? nA : cA + (size_t)(t + 2) * kstep; const char* b2 = last ? nB : cB + (size_t)(t + 2) * kstep;
            const char* a3 = a2 + kstep; const char* b3 = b2 + kstep;
            const bool sel = last;
            PG8_LDB(B0, 0, 0); PG8_LDB(B1, 0, 1); PG8_SCHED; PG8_LDA(At, 0, 0); PG8_STAGE(PG8_SA(1, 1), a1, voffA[1]);
            PG8_WAIT_V(8); PG8_WAIT_L(0); PG8_BAR; PG8_MMA(0, 0, At, B0); PG8_MMA(0, 1, At, B1); PG8_BAR; PG8_SCHED;
            PG8_LDA(At, 0, 1); PG8_STAGE(PG8_SB(0, 0), b2, voffB); PG8_STAGE(PG8_SB(0, 1), b2 + hstepB, voffB); PG8_STAGE_SEL(PG8_SA(0, 0), a2, sel, nvoffA[0], voffA[0]);
            PG8_WAIT_V(8); PG8_WAIT_L(0); PG8_BAR; if (cur.hf < 0) { PG8_MMA(1, 0, At, B0); PG8_MMA(1, 1, At, B1); } PG8_BAR; PG8_SCHED;
            PG8_LDB(B0, 1, 0); PG8_LDB(B1, 1, 1); PG8_SCHED; PG8_LDA(At, 1, 0); PG8_STAGE_SEL(PG8_SA(0, 1), a2, sel, nvoffA[1], voffA[1]);
            PG8_WAIT_V(8); PG8_WAIT_L(0); PG8_BAR; PG8_MMA(0, 0, At, B0); PG8_MMA(0, 1, At, B1); PG8_BAR; PG8_SCHED;
            PG8_LDA(At, 1, 1); PG8_STAGE(PG8_SB(1, 0), b3, voffB); PG8_STAGE(PG8_SB(1, 1), b3 + hstepB, voffB); PG8_STAGE_SEL(PG8_SA(1, 0), a3, sel, nvoffA[0], voffA[0]);
            PG8_WAIT_V(8); PG8_WAIT_L(0); PG8_BAR; if (cur.hf < 0) { PG8_MMA(1, 0, At, B0); PG8_MMA(1, 1, At, B1); } PG8_BAR; PG8_SCHED;
        }
        if constexpr (ALIGN_EPI) { if (wr == 0) PG8_BAR; }
        if constexpr (FP8) asm volatile("s_nop 15\n\ts_nop 7" ::: "memory");
        E(acc, cur, wr, wc, fr, fq);
        if (!has_next) break;
#pragma unroll
        for (int a = 0; a < 2; ++a)
#pragma unroll
            for (int b = 0; b < 2; ++b)
#pragma unroll
                for (int m = 0; m < 4; ++m)
#pragma unroll
                    for (int n = 0; n < 2; ++n) { acc[a][b][m][n] = (f32x4){0.f, 0.f, 0.f, 0.f}; if constexpr (FP8) asm volatile("" : "+v"(acc[a][b][m][n])); }
        cur = nxt; cA = nA; cB = nB; ++ui;
        if constexpr (!GATHER) { voffA[1][0] = nvoffA[1][0]; voffA[1][1] = nvoffA[1][1]; }
        if constexpr (GATHER) {
#pragma unroll
            for (int h = 0; h < 2; ++h)
#pragma unroll
                for (int i = 0; i < 2; ++i) voffA[h][i] = nvoffA[h][i]; }
        if constexpr (ALIGN_EPI) { if (wr == 1) PG8_BAR; }
    }
    PG8_WAIT_V(0);
    if constexpr (!ALIGN_EPI) { if (wr == 0) PG8_BAR; }
    PG8_BAR;
#undef PG8_SA
#undef PG8_SB
#undef PG8_STAGE
#undef PG8_STAGE_SEL
#undef PG8_LDA
#undef PG8_LDB
#undef PG8_MMA
#undef PG8_WAIT_V
#undef PG8_WAIT_L
#undef PG8_BAR
#undef PG8_SCHED
#undef PG8_GATHER_OFF
}
template <class F> struct EpiW {
    F f; int nnmod;
    __device__ __forceinline__ void operator()(f32x4 (&acc)[2][2][4][2], const Unit& u, int wr, int wc, int fr, int fq) const {
        const int pn = nnmod ? (u.pn % nnmod) : u.pn; const int row0 = u.pm * BM + wr * 64 + fr, col0 = pn * BM + wc * 32 + 4 * fq;
        float rsv[2][4]; int auxv[2][4]; typename F::Raw rw[2][4];
#pragma unroll
        for (int ai = 0; ai < 2; ++ai) { if (ai == 1 && u.hf >= 0) break;
#pragma unroll
            for (int m = 0; m < 4; ++m) { const int row = row0 + (u.hf < 0 ? ai : u.hf) * HALF + m * 16; rw[ai][m] = f.raw(row, fq); auxv[ai][m] = f.aux(row); } }
#pragma unroll
        for (int ai = 0; ai < 2; ++ai) { if (ai == 1 && u.hf >= 0) break;
#pragma unroll
            for (int m = 0; m < 4; ++m) rsv[ai][m] = f.fin(rw[ai][m]); }
        if constexpr (F::HAS_PRE) {
#pragma unroll
            for (int ai = 0; ai < 2; ++ai) { if (ai == 1 && u.hf >= 0) break;
#pragma unroll
                for (int m = 0; m < 4; ++m) { int row = row0 + (u.hf < 0 ? ai : u.hf) * HALF + m * 16; if ((m & 1) == 0) asm volatile("" : "+v"(row) :: "memory");
#pragma unroll
                    for (int bj = 0; bj < 2; ++bj) f.pre(row, col0 + bj * HALF, acc[ai][bj][m][0], acc[ai][bj][m][1]); } }
        }
#pragma unroll
        for (int ai = 0; ai < 2; ++ai) { if (ai == 1 && u.hf >= 0) break;
#pragma unroll
            for (int m = 0; m < 4; ++m) {
                int row = row0 + (u.hf < 0 ? ai : u.hf) * HALF + m * 16; asm volatile("" : "+v"(row) :: "memory");
#pragma unroll
                for (int bj = 0; bj < 2; ++bj) { const int col = col0 + bj * HALF;
                    float s = f(row, col, acc[ai][bj][m][0], acc[ai][bj][m][1], rsv[ai][m], auxv[ai][m]);
                    if constexpr (F::HAS_STAT) { s = fq_sum(s); if (fq == 0) f.stat(row, col, s); } }
            } }
    }
};
}


struct Raw32 { f32x4 a, b; };
__device__ __forceinline__ Raw32 raw32(const float* ss, int row, int fq) { Raw32 r; r.a = *(const f32x4*)(ss + (size_t)row * 32 + 8 * fq); r.b = *(const f32x4*)(ss + (size_t)row * 32 + 8 * fq + 4); return r; }
__device__ __forceinline__ float fin32(const Raw32& r) { return __builtin_amdgcn_rsqf(fq_sum(((r.a[0] + r.a[1]) + (r.a[2] + r.a[3])) + ((r.b[0] + r.b[1]) + (r.b[2] + r.b[3]))) * (1.0f / DM) + EPS); }
__device__ __forceinline__ float ssq8(f32x4 v0, f32x4 v1) { return ((v0[0] * v0[0] + v0[1] * v0[1]) + (v0[2] * v0[2] + v0[3] * v0[3])) + ((v1[0] * v1[0] + v1[1] * v1[1]) + (v1[2] * v1[2] + v1[3] * v1[3])); }
struct EpiIn {
    static constexpr bool HAS_STAT = true, HAS_PRE = false;
    const float* ssx; bf16_t *XL, *GY, *CQKV, *KR; float *SSQ, *SSKV; const float* tab;
    __device__ __forceinline__ int aux(int) const { return 0; }
    typedef Raw32 Raw;
    __device__ __forceinline__ Raw raw(int row, int fq) const { return raw32(ssx, row, fq); }
    __device__ __forceinline__ float fin(const Raw& r) const { return fin32(r); }
    __device__ __forceinline__ float operator()(int row, int col, f32x4 v0, f32x4 v1, float rs, int) const {
        if (col >= INC) return 0.f;
        v0 *= rs; v1 *= rs;
        if (col < 512) { store8bf_x(XL + (size_t)row * 512 + col, col, v0, v1); return 0.f; }
        if (col < 1024) { const int c = col - 512; f32x4 g0, g1;
#pragma unroll
            for (int e = 0; e < 4; ++e) { g0[e] = gelu_tanh(v0[e]); g1[e] = gelu_tanh(v1[e]); }
            store8bf_x(GY + (size_t)row * 512 + c, c, g0, g1); return 0.f; }
        if (col < 1408) { const int c = col - 1024; store8bf_x(CQKV + (size_t)row * 384 + c, c, v0, v1); return ssq8(v0, v1); }
        { const int i0 = col - 1408; f32x4 o1, o2;
#pragma unroll
          for (int e = 0; e < 4; ++e) { const float c = tab[(size_t)row * 32 + 2 * (i0 + e)], s = tab[(size_t)row * 32 + 2 * (i0 + e) + 1]; o1[e] = v0[e] * c - v1[e] * s; o2[e] = v1[e] * c + v0[e] * s; }
          store4bf(KR + (size_t)row * 32 + i0, o1); store4bf(KR + (size_t)row * 32 + 16 + i0, o2); return 0.f; }
    }
    __device__ __forceinline__ void stat(int row, int col, float s) const {
        if (col >= 1024 && col < 1280) SSQ[(size_t)row * 8 + ((col - 1024) >> 5)] = s;
        else if (col >= 1280 && col < 1408) SSKV[(size_t)row * 4 + ((col - 1280) >> 5)] = s;
    }
};
struct EpiQ {
    static constexpr bool HAS_STAT = false, HAS_PRE = false;
    const float* ssq; bf16_t* QF; const float* tab;
    __device__ __forceinline__ int aux(int) const { return 0; }
    typedef f32x2_t Raw;
    __device__ __forceinline__ Raw raw(int row, int fq) const { return *(const f32x2_t*)(ssq + (size_t)row * 8 + 2 * fq); }
    __device__ __forceinline__ float fin(const Raw& r) const { return __builtin_amdgcn_rsqf(fq_sum(r[0] + r[1]) * (1.0f / QLORA) + EPS) * QSCALE; }
    __device__ __forceinline__ float operator()(int row, int col, f32x4 v0, f32x4 v1, float rs, int) const {
        v0 *= rs; v1 *= rs;
        const int j = col % DQK;
        if (j < 64) { store8bf_x(QF + (size_t)row * QW + col, col, v0, v1); }
        else { const int i0 = j - 64; f32x4 o1, o2;
#pragma unroll
            for (int e = 0; e < 4; ++e) { const float c = tab[(size_t)row * 32 + 2 * (i0 + e)], s = tab[(size_t)row * 32 + 2 * (i0 + e) + 1]; o1[e] = v0[e] * c - v1[e] * s; o2[e] = v1[e] * c + v0[e] * s; }
            store4bf(QF + (size_t)row * QW + col, o1); store4bf(QF + (size_t)row * QW + col + 16, o2); }
        return 0.f;
    }
    __device__ __forceinline__ void stat(int, int, float) const {}
};
struct EpiKV {
    static constexpr bool HAS_STAT = false, HAS_PRE = false;
    const float* sskv; bf16_t *KN, *VT;
    __device__ __forceinline__ int aux(int) const { return 0; }
    typedef float Raw;
    __device__ __forceinline__ Raw raw(int row, int fq) const { return sskv[(size_t)row * 4 + fq]; }
    __device__ __forceinline__ float fin(const Raw& r) const { return __builtin_amdgcn_rsqf(fq_sum(r) * (1.0f / KVLORA) + EPS); }
    __device__ __forceinline__ float operator()(int row, int col, f32x4 v0, f32x4 v1, float rs, int) const {
        v0 *= rs; v1 *= rs;
        const int h = col >> 7, j = col & 127;
        if (j < 64) { bf16_t* kn = KN + (size_t)row * 512 + h * 64 + j; store8bf_x(kn, j, v0, v1); }
        else { const int d = j - 64, b = row / SEQ, s = row % SEQ; bf16_t* vt = VT + ((size_t)(b * NH + h) * VH + d) * SEQ + s;
#pragma unroll
            for (int e = 0; e < 4; ++e) { vt[(size_t)e * SEQ] = (bf16_t)f2bf(v0[e]); vt[(size_t)(e + 16) * SEQ] = (bf16_t)f2bf(v1[e]); } }
        return 0.f;
    }
    __device__ __forceinline__ void stat(int, int, float) const {}
};
struct EpiRes {
    static constexpr bool HAS_STAT = true, HAS_PRE = true;
    bf16_t* XR; unsigned char* X8; float* SSX; float accscale;
    typedef int Raw;
    __device__ __forceinline__ Raw raw(int, int) const { return 0; }
    __device__ __forceinline__ float fin(const Raw&) const { return 1.f; }
    __device__ __forceinline__ int aux(int) const { return 0; }
    __device__ __forceinline__ void pre(int row, int col, f32x4& v0, f32x4& v1) const {
        const size_t o = (size_t)row * DM + col;
        { const u32x2 a = *(const u32x2*)(XR + o), b = *(const u32x2*)(XR + o + 16);
            v0 = v0 * accscale + (f32x4){bf2f(a.x & 0xffff), bf2f(a.x >> 16), bf2f(a.y & 0xffff), bf2f(a.y >> 16)}; v1 = v1 * accscale + (f32x4){bf2f(b.x & 0xffff), bf2f(b.x >> 16), bf2f(b.y & 0xffff), bf2f(b.y >> 16)}; }
    }
    __device__ __forceinline__ float operator()(int row, int col, f32x4 a, f32x4 b, float, int) const {
        const size_t o = (size_t)row * DM + col;
        store8bf_x(XR + o, col, a, b);
        if (X8) { unsigned char* x8 = X8 + o; *(unsigned*)x8 = pk4_fp8(a[0] * F8_XS, a[1] * F8_XS, a[2] * F8_XS, a[3] * F8_XS); *(unsigned*)(x8 + 16) = pk4_fp8(b[0] * F8_XS, b[1] * F8_XS, b[2] * F8_XS, b[3] * F8_XS); }
        return ssq8(a, b);
    }
    __device__ __forceinline__ void stat(int row, int col, float s) const { SSX[(size_t)row * 32 + (col >> 5)] = s; }
};
template <bool F8> struct GURaw { typedef Raw32 T; }; template <> struct GURaw<true> { typedef float T; };
template <bool F8, bool O8 = F8> struct EpiGU {
    static constexpr bool HAS_STAT = false, HAS_PRE = false;
    const float* ssx; const int* rowtok; bf16_t* ACT; int ldact;
    __device__ __forceinline__ int aux(int) const { return 0; }
    typedef typename GURaw<F8>::T Raw;
    __device__ __forceinline__ Raw raw(int row, int fq) const { if constexpr (F8) return ssx[row]; else return raw32(ssx, row, fq); }
    __device__ __forceinline__ float fin(const Raw& r) const { if constexpr (F8) return r; else return fin32(r); }
    __device__ __forceinline__ float operator()(int row, int col, f32x4 v0, f32x4 v1, float rs, int) const {
        f32x4 o;
        const float sc = F8 ? rs * (1.0f / (F8_XS * F8_WS)) : rs;
#pragma unroll
        for (int e = 0; e < 4; ++e) { const float g = v0[e] * sc, u = v1[e] * sc; o[e] = g * sigmoidf_(g) * u; }
        if (O8) *(unsigned*)((unsigned char*)ACT + (size_t)row * ldact + (col >> 5) * 16 + (col & 31)) = pk4_fp8(o[0] * F8_AS, o[1] * F8_AS, o[2] * F8_AS, o[3] * F8_AS);
        else store4bf_x(ACT + (size_t)row * ldact + (col >> 5) * 16 + (col & 31), col, o);
        return 0.f;
    }
    __device__ __forceinline__ void stat(int, int, float) const {}
};
struct EpiED {
    static constexpr bool HAS_STAT = false, HAS_PRE = false;
    const float* roww; const int* rowslot; bf16_t* Y;
    typedef float Raw;
    __device__ __forceinline__ Raw raw(int row, int) const { return roww[row]; }
    __device__ __forceinline__ float fin(const Raw& r) const { return r; }
    __device__ __forceinline__ int aux(int row) const { return rowslot[row]; }
    __device__ __forceinline__ float operator()(int, int col, f32x4 v0, f32x4 v1, float w, int slot) const {
        if (slot < 0) return 0.f;
        const float ws_ = w * (1.0f / (F8_AS * F8_WS)); store8bf_x(Y + (size_t)slot * DM + col, col, v0 * ws_, v1 * ws_); return 0.f;
    }
    __device__ __forceinline__ void stat(int, int, float) const {}
};

template <class F, bool ALIGN, bool FP8 = false>
__device__ __forceinline__ void gemm_static(int wv, const bf16_t* A, int lda, const bf16_t* Bt, int ldb, int M, int N, int K, const F& f, int bid, int nb, unsigned char* smem) {
    pg8::Gemm g{A, Bt, lda, ldb, K, nullptr}; pg8::StaticOrder S; S.init(M / 256, N / 256, nb, bid); pg8::EpiW<F> E{f, 0};
    pg8::gemm_phase<pg8::EpiW<F>, pg8::StaticOrder, ALIGN, false, FP8>(wv, (PG8_LAS unsigned char*)smem, g, S, E);
}

__device__ __forceinline__ void expert_offsets(const int* cnt, int (&off)[NE + 1]) {
    int o = 0;
#pragma unroll
    for (int e = 0; e < NE; ++e) { off[e] = o; o += (cnt[e] + 255) & ~255; }
    off[NE] = o;
}

constexpr int XCS_LD = 520;
constexpr int LRU_XL = 0, LRU_XCS = 35 * 1024, LRU_GR = LRU_XCS + 16 * XCS_LD * 2, LRU_GI = LRU_GR + 16 * 512 * 4, LRU_GY = LRU_GI + 16 * 512 * 4, LRU_LDS = LRU_GY + 32 * 1024;
template <bool FIN>
__device__ __forceinline__ void lru_phase(PP p, int wv, int l, int bid, int nb, unsigned char* smem) {
    const int c = otid(wv), lane = c & 63, fr = lane & 15, fq = lane >> 4;
    unsigned char* ws = p->ws;
    const bf16_t* XL = (const bf16_t*)(ws + WS_XL); const bf16_t* GY = (const bf16_t*)(ws + WS_GY); bf16_t* MIX = (bf16_t*)(ws + WS_MIX); float* SUM = (float*)(ws + WS_SUM); unsigned* LAU = (unsigned*)(ws + WS_LAU);
    bf16_t* xls = (bf16_t*)(smem + LRU_XL); bf16_t* xcs = (bf16_t*)(smem + LRU_XCS); float* gr = (float*)(smem + LRU_GR); float* gi = (float*)(smem + LRU_GI); bf16_t* gys = (bf16_t*)(smem + LRU_GY);
    bf16x8 wf[2][4][2];
    { const bf16_t* lw = (const bf16_t*)(ws + WS_LW) + (size_t)((l * 8 + wv) * 2) * 4096;
#pragma unroll
      for (int w = 0; w < 2; ++w)
#pragma unroll
          for (int dt = 0; dt < 4; ++dt)
#pragma unroll
              for (int ks = 0; ks < 2; ++ks) wf[w][dt][ks] = *(const bf16x8*)(lw + (size_t)w * 4096 + (dt * 16 + fr) * 64 + ks * 32 + fq * 8); }
    const float ba = p->lru_ba[l * LRU_W + c], bx = p->lru_bx[l * LRU_W + c];
    const float lam = p->lru_lambda[l * LRU_W + c]; const float sp8 = -8.0f * 1.4426950408889634f * log1pf(expf(-lam));
    const float cw0 = p->conv_w[(l * 4 + 0) * LRU_W + c], cw1 = p->conv_w[(l * 4 + 1) * LRU_W + c], cw2 = p->conv_w[(l * 4 + 2) * LRU_W + c], cw3 = p->conv_w[(l * 4 + 3) * LRU_W + c], cb = p->conv_b[l * LRU_W + c];
    for (int ch = bid; ch < T / 64; ch += nb) {
        const int t0 = ch * 64, s0 = t0 % SEQ;
        u32x4 pre[5], pg[4];
#define LRU_LOAD(hf) do { _Pragma("unroll") for (int j = 0; j < 5; ++j) { const int pc = c + 512 * j; const int row = pc >> 6, tk = t0 + 32 * (hf) - 3 + row; \
            pre[j] = (u32x4){0u, 0u, 0u, 0u}; if (pc < 2240 && !((hf) == 0 && s0 == 0 && row < 3)) pre[j] = *(const u32x4*)(XL + (size_t)tk * 512 + (pc & 63) * 8); } \
            if (FIN) { _Pragma("unroll") for (int j = 0; j < 4; ++j) { const int pc = c + 512 * j; pg[j] = *(const u32x4*)(GY + (size_t)(t0 + 32 * (hf) + (pc >> 6)) * 512 + (pc & 63) * 8); } } } while (0)
#define LRU_STORE() do { _Pragma("unroll") for (int j = 0; j < 5; ++j) { const int pc = c + 512 * j; if (pc < 2240) *(u32x4*)(xls + pc * 8) = pre[j]; } \
            if (FIN) { _Pragma("unroll") for (int j = 0; j < 4; ++j) *(u32x4*)(gys + (c + 512 * j) * 8) = pg[j]; } } while (0)
        LRU_LOAD(0);
        float h = 0.f, Aacc = 1.f;
        if (FIN) { const int cfirst = (t0 / SEQ) * (SEQ / 64);
            for (int cc = cfirst; cc < ch; cc += 8) { float a_[8], h_[8];
#pragma unroll
                for (int q = 0; q < 8; ++q) { const bool ok = cc + q < ch; a_[q] = ok ? SUM[(size_t)(cc + q) * 1024 + c] : 1.f; h_[q] = ok ? SUM[(size_t)(cc + q) * 1024 + 512 + c] : 0.f; }
#pragma unroll
                for (int q = 0; q < 8; ++q) h = a_[q] * h + h_[q]; } }
        LRU_STORE();
        __syncthreads();
#pragma unroll 1
        for (int hf = 0; hf < 2; ++hf) {
            if (hf == 0) LRU_LOAD(1);
#pragma unroll 1
            for (int sub = 0; sub < 2; ++sub) {
                const int tb = t0 + 32 * hf + 16 * sub;
                const bf16_t* xr = xls + (16 * sub) * 512 + c;
                { float x0 = bf2f(xr[0]), x1 = bf2f(xr[512]), x2 = bf2f(xr[1024]);
#pragma unroll 4
                  for (int tt = 0; tt < 16; ++tt) { const float x3 = bf2f(xr[(tt + 3) * 512]); const float xcv = cb + cw0 * x0 + cw1 * x1 + cw2 * x2 + cw3 * x3; x0 = x1; x1 = x2; x2 = x3; xcs[tt * XCS_LD + c] = (bf16_t)f2bf(xcv); } }
                __syncthreads();
                { f32x4 ar[4], ai[4];
#pragma unroll
                  for (int dt = 0; dt < 4; ++dt) { ar[dt] = (f32x4){0.f, 0.f, 0.f, 0.f}; ai[dt] = (f32x4){0.f, 0.f, 0.f, 0.f}; }
#pragma unroll
                  for (int ks = 0; ks < 2; ++ks) { const bf16x8 af = *(const bf16x8*)(xcs + fr * XCS_LD + wv * 64 + ks * 32 + fq * 8);
#pragma unroll
                      for (int dt = 0; dt < 4; ++dt) { ar[dt] = __builtin_amdgcn_mfma_f32_16x16x32_bf16(af, wf[0][dt][ks], ar[dt], 0, 0, 0); ai[dt] = __builtin_amdgcn_mfma_f32_16x16x32_bf16(af, wf[1][dt][ks], ai[dt], 0, 0, 0); } }
#pragma unroll
                  for (int dt = 0; dt < 4; ++dt)
#pragma unroll
                      for (int r = 0; r < 4; ++r) { gr[(4 * fq + r) * 512 + wv * 64 + dt * 16 + fr] = ar[dt][r]; gi[(4 * fq + r) * 512 + wv * 64 + dt * 16 + fr] = ai[dt][r]; } }
                __syncthreads();
                { float x0 = bf2f(xr[0]), x1 = bf2f(xr[512]), x2 = bf2f(xr[1024]);
#pragma unroll 4
                  for (int tt = 0; tt < 16; ++tt) {
                    const float x3 = bf2f(xr[(tt + 3) * 512]); const float xcv = cb + cw0 * x0 + cw1 * x1 + cw2 * x2 + cw3 * x3; x0 = x1; x1 = x2; x2 = x3;
                    const float r = sigmoidf_(gr[tt * 512 + c] + ba), ig = sigmoidf_(gi[tt * 512 + c] + bx);
                    const float a = __builtin_amdgcn_exp2f(sp8 * r); float mult = __builtin_amdgcn_sqrtf(1.0f - a * a);
                    const int t = tb + tt; if ((t % SEQ) == 0) mult = 1.0f;
                    const float u = mult * (ig * xcv);
                    h = a * h + u; Aacc *= a;
                    if (!FIN) LAU[(size_t)t * 512 + c] = pk2(sp8 * r, u);
                    if (FIN) MIX[(size_t)t * DM + c] = (bf16_t)f2bf(h * bf2f(gys[(16 * sub + tt) * 512 + c]));
                  } }
                __syncthreads();
            }
            if (hf == 0) { LRU_STORE(); __syncthreads(); }
        }
        if (!FIN) { SUM[(size_t)ch * 1024 + c] = Aacc; SUM[(size_t)ch * 1024 + 512 + c] = h; }
#undef LRU_LOAD
#undef LRU_STORE
    }
}

__device__ __forceinline__ void lru_sum_phase(PP p, int wv, int l, int bid, int nb, unsigned char* smem) {
    const int tid = otid(wv), lane = tid & 63, fr = lane & 15, fq = lane >> 4;
    unsigned char* ws = p->ws;
    const bf16_t* XL = (const bf16_t*)(ws + WS_XL); float* SUM = (float*)(ws + WS_SUM); unsigned* LAU = (unsigned*)(ws + WS_LAU);
    float* cwl = (float*)smem;
    for (int i = tid; i < 5 * LRU_W; i += NTHR) { const int k = i >> 9, c = i & 511; cwl[i] = k < 4 ? p->conv_w[(l * 4 + k) * LRU_W + c] : p->conv_b[l * LRU_W + c]; }
    unsigned char* wl = smem + 10240 + wv * 16384;
    { const bf16_t* lw = (const bf16_t*)(ws + WS_LW) + (size_t)((l * 8 + wv) * 2) * 4096;
#pragma unroll
      for (int j = 0; j < 16; ++j) { const int pc = lane + 64 * j, row = pc >> 3, piece = pc & 7; *(u32x4*)(wl + row * 128 + ((piece ^ (row & 7)) << 4)) = *(const u32x4*)(lw + row * 64 + piece * 8); } }
    float ba[4], bx[4], sp8[4];
#pragma unroll
    for (int dt = 0; dt < 4; ++dt) { const int c = l * LRU_W + wv * 64 + dt * 16 + fr; ba[dt] = p->lru_ba[c]; bx[dt] = p->lru_bx[c]; sp8[dt] = -8.0f * 1.4426950408889634f * log1pf(expf(-p->lru_lambda[c])); }
    bf16x8 idf[2];
#pragma unroll
    for (int q = 0; q < 2; ++q) { const int j = 16 * q + fr - 8 * fq; u32x4 w = {0u, 0u, 0u, 0u};
#pragma unroll
        for (int d = 0; d < 4; ++d) { if (j == 2 * d) w[d] = 0x3F80u; if (j == 2 * d + 1) w[d] = 0x3F800000u; }
        idf[q] = __builtin_bit_cast(bf16x8, w); }
    __syncthreads();
    const int cbase = wv * 64 + 8 * fq;
    for (int ch = bid; ch < T / 64; ch += nb) {
        const int t0 = ch * 64; const bool seqstart = (t0 % SEQ) == 0;
        float Ar[4] = {1.f, 1.f, 1.f, 1.f}, Hr[4] = {0.f, 0.f, 0.f, 0.f};
        u32x4 xc_[2][4];
#define LRS_LOAD(dst, sub_) do { _Pragma("unroll") for (int ks = 0; ks < 2; ++ks) _Pragma("unroll") for (int tap = 0; tap < 4; ++tap) { const int rel = 16 * (sub_) + fr - 3 + tap; \
            dst[ks][tap] = (u32x4){0u, 0u, 0u, 0u}; if (!(seqstart && rel < 0)) dst[ks][tap] = *(const u32x4*)(XL + (size_t)(t0 + rel) * LRU_W + cbase + 32 * ks); } } while (0)
        LRS_LOAD(xc_, 0);
#pragma unroll 1
        for (int sub = 0; sub < 4; ++sub) {
            unsigned oz = 0u; asm volatile("" : "+v"(oz)); const LAS float* cwo = (const LAS float*)((const LAS unsigned char*)smem + oz); const LAS unsigned char* wlo = (const LAS unsigned char*)smem + oz + 10240 + wv * 16384;
            bf16x8 af[2];
#pragma unroll
            for (int ks = 0; ks < 2; ++ks) { u32x4 pk;
#pragma unroll
                for (int hj = 0; hj < 2; ++hj) { const LAS float* wp = cwo + cbase + 32 * ks + 4 * hj; f32x4 acc = *(const LAS f32x4*)(wp + 4 * LRU_W);
#pragma unroll
                    for (int tap = 0; tap < 4; ++tap) { const unsigned d0 = xc_[ks][tap][2 * hj], d1 = xc_[ks][tap][2 * hj + 1];
                        const f32x4 xv = {__uint_as_float(d0 << 16), __uint_as_float(d0 & 0xffff0000u), __uint_as_float(d1 << 16), __uint_as_float(d1 & 0xffff0000u)};
                        acc += *(const LAS f32x4*)(wp + tap * LRU_W) * xv; }
                    pk[2 * hj] = pk2(acc[0], acc[1]); pk[2 * hj + 1] = pk2(acc[2], acc[3]); }
                af[ks] = __builtin_bit_cast(bf16x8, pk); }
            if (sub < 3) LRS_LOAD(xc_, sub + 1);
            f32x4 ar[4], ai[4], xd[4];
#pragma unroll
            for (int dt = 0; dt < 4; ++dt) { ar[dt] = (f32x4){0.f, 0.f, 0.f, 0.f}; ai[dt] = (f32x4){0.f, 0.f, 0.f, 0.f}; }
#pragma unroll
            for (int ks = 0; ks < 2; ++ks)
#pragma unroll
                for (int dt = 0; dt < 4; ++dt) { const LAS unsigned char* wp_ = wlo + (dt * 16 + fr) * 128 + (((ks * 4 + fq) ^ (fr & 7)) << 4);
                    ar[dt] = __builtin_amdgcn_mfma_f32_16x16x32_bf16(af[ks], *(const LAS bf16x8*)wp_, ar[dt], 0, 0, 0); ai[dt] = __builtin_amdgcn_mfma_f32_16x16x32_bf16(af[ks], *(const LAS bf16x8*)(wp_ + 64 * 128), ai[dt], 0, 0, 0); }
#pragma unroll
            for (int dt = 0; dt < 4; ++dt) xd[dt] = __builtin_amdgcn_mfma_f32_16x16x32_bf16(af[dt >> 1], idf[dt & 1], (f32x4){0.f, 0.f, 0.f, 0.f}, 0, 0, 0);
            u32x4* lp = (u32x4*)(LAU + ((size_t)((t0 >> 4) + sub) * 8 + wv) * 1024 + lane * 16);
#pragma unroll
            for (int dt = 0; dt < 4; ++dt) { float Al = 1.f, Hl = 0.f; u32x4 lw4;
#pragma unroll
                for (int r = 0; r < 4; ++r) {
                    const float rg = sigmoidf_(ar[dt][r] + ba[dt]), ig = sigmoidf_(ai[dt][r] + bx[dt]);
                    const float la = sp8[dt] * rg, a = __builtin_amdgcn_exp2f(la); float mult = __builtin_amdgcn_sqrtf(1.0f - a * a);
                    if (r == 0) { if (seqstart && sub == 0 && fq == 0) mult = 1.0f; }
                    const float u = mult * (ig * xd[dt][r]);
                    Hl = a * Hl + u; Al *= a;
                    lw4[r] = pk2(la, u);
                }
                lp[dt] = lw4;
                { const auto sa = __builtin_amdgcn_permlane16_swap(__float_as_uint(Al), __float_as_uint(Al), false, false), sh = __builtin_amdgcn_permlane16_swap(__float_as_uint(Hl), __float_as_uint(Hl), false, false);
                  Hl = __uint_as_float(sh[0]) * __uint_as_float(sa[1]) + __uint_as_float(sh[1]); Al = __uint_as_float(sa[0]) * __uint_as_float(sa[1]); }
                { const auto sa = __builtin_amdgcn_permlane32_swap(__float_as_uint(Al), __float_as_uint(Al), false, false), sh = __builtin_amdgcn_permlane32_swap(__float_as_uint(Hl), __float_as_uint(Hl), false, false);
                  Hl = __uint_as_float(sh[0]) * __uint_as_float(sa[1]) + __uint_as_float(sh[1]); Al = __uint_as_float(sa[0]) * __uint_as_float(sa[1]); }
                Hr[dt] = Al * Hr[dt] + Hl; Ar[dt] *= Al; }
        }
#undef LRS_LOAD
        if (fq == 0) {
#pragma unroll
            for (int dt = 0; dt < 4; ++dt) { SUM[(size_t)ch * 1024 + wv * 64 + dt * 16 + fr] = Ar[dt]; SUM[(size_t)ch * 1024 + 512 + wv * 64 + dt * 16 + fr] = Hr[dt]; } }
    }
}

__device__ __forceinline__ void lru_scan_phase(PP p, int wv, int bid, int nb) {
    const int c = otid(wv); unsigned char* ws = p->ws;
    const bf16_t* GY = (const bf16_t*)(ws + WS_GY); bf16_t* MIX = (bf16_t*)(ws + WS_MIX); const float* SUM = (const float*)(ws + WS_SUM); const unsigned* LAU = (const unsigned*)(ws + WS_LAU);
    const int lofs = (c >> 6) * 1024 + (c & 15) * 16 + ((c >> 4) & 3) * 4;
    for (int ch = bid; ch < T / 64; ch += nb) {
        const int t0 = ch * 64; float h = 0.f;
        { const int cfirst = (t0 / SEQ) * (SEQ / 64);
          for (int cc = cfirst; cc < ch; cc += 8) { float a_[8], h_[8];
#pragma unroll
              for (int q = 0; q < 8; ++q) { const bool ok = cc + q < ch; a_[q] = ok ? SUM[(size_t)(cc + q) * 1024 + c] : 1.f; h_[q] = ok ? SUM[(size_t)(cc + q) * 1024 + 512 + c] : 0.f; }
#pragma unroll
              for (int q = 0; q < 8; ++q) h = a_[q] * h + h_[q]; } }
#pragma unroll 1
        for (int sub = 0; sub < 4; ++sub) { u32x4 lu[4]; unsigned short gy[16];
#pragma unroll
            for (int g4 = 0; g4 < 4; ++g4) lu[g4] = *(const u32x4*)(LAU + (size_t)((t0 >> 4) + sub) * 8192 + lofs + g4 * 256);
#pragma unroll
            for (int tt = 0; tt < 16; ++tt) gy[tt] = GY[(size_t)(t0 + 16 * sub + tt) * 512 + c];
#pragma unroll
            for (int tt = 0; tt < 16; ++tt) { const unsigned w = lu[tt >> 2][tt & 3]; const float a = __builtin_amdgcn_exp2f(bf2f((unsigned short)(w & 0xffffu))), u = bf2f((unsigned short)(w >> 16));
                h = a * h + u; MIX[(size_t)(t0 + 16 * sub + tt) * DM + c] = (bf16_t)f2bf(h * bf2f(gy[tt])); }
        }
    }
}

__device__ __forceinline__ int pi32(int r) { return (r & 0x13) | ((r & 4) << 1) | ((r & 8) >> 1); }
__device__ __forceinline__ unsigned cvtpk(float lo, float hi) { return pk2(lo, hi); }
constexpr int AT_KN = 0, AT_KR = 8192, AT_VT = 12288, AT_SLOT = 20480, AT_NSLOT = 4;
constexpr float AT_THR = 8.0f;
__device__ __forceinline__ float max3f(float a, float b, float c) { float r; asm("v_max3_f32 %0, %1, %2, %3" : "=v"(r) : "v"(a), "v"(b), "v"(c)); return r; }
#define AT_WAITV(n) asm volatile("s_waitcnt vmcnt(" #n ")" ::: "memory")
__device__ __forceinline__ void attn_unit(int wv, int b, int h, int qb, const bf16_t* QF, const bf16_t* KN, const bf16_t* KR, const bf16_t* VT, bf16_t* MIX, LAS unsigned char* lds) {
    const int tid = otid(wv), lane = tid & 63, wid = __builtin_amdgcn_readfirstlane(tid >> 6), r32 = lane & 31, hi = lane >> 5;
    const size_t rowbase = (size_t)b * SEQ; const int q0 = qb * 256, NT = (q0 + 256) / 64;
    const int krow = 8 * wid + (lane >> 3), kch = (lane & 7) ^ ((krow >> 1) & 7);
    const bf16_t* ksrc = KN + (rowbase + krow) * 512 + h * 64 + kch * 8;
    const bf16_t* vsrc = VT + ((size_t)(b * NH + h) * VH + krow) * SEQ + kch * 8;
    const int rrow = 16 * (wid & 3) + (lane >> 2), rch = (lane & 3) ^ ((rrow >> 2) & 3);
    const bf16_t* rsrc = KR + (rowbase + rrow) * 32 + rch * 8;
    const unsigned wofs = (unsigned)wid * 1024u;
#define AT_ISSUE(t, slot) do { LAS unsigned char* sb_ = lds + (slot) * AT_SLOT; \
        __builtin_amdgcn_global_load_lds((const unsigned*)(ksrc + (size_t)(t) * 64 * 512), (LAS unsigned*)(sb_ + AT_KN + wofs), 16, 0, 0); \
        __builtin_amdgcn_global_load_lds((const unsigned*)(vsrc + (size_t)(t) * 64), (LAS unsigned*)(sb_ + AT_VT + wofs), 16, 0, 0); \
        if (wid < 4) __builtin_amdgcn_global_load_lds((const unsigned*)(rsrc + (size_t)(t) * 64 * 32), (LAS unsigned*)(sb_ + AT_KR + wofs), 16, 0, 0); } while (0)
    AT_ISSUE(0, 0); AT_ISSUE(1, 1);
    bf16x8 qf[6];
#pragma unroll
    for (int s = 0; s < 6; ++s) qf[s] = *(const bf16x8*)(QF + (rowbase + q0 + 32 * wid + r32) * QW + h * DQK + 16 * s + 8 * hi);
    __builtin_amdgcn_s_waitcnt(0x0F70);
    const int pr = pi32(r32);
    int kno[2], kro[2], vto[2];
#pragma unroll
    for (int hf = 0; hf < 2; ++hf) { const int row = 32 * hf + pr; kno[hf] = AT_KN + row * 128 + ((hi ^ ((row >> 1) & 7)) << 4); kro[hf] = AT_KR + row * 64 + ((hi ^ ((row >> 2) & 3)) << 4);
        const int dr = 32 * hf + r32; vto[hf] = AT_VT + dr * 128 + ((hi ^ ((dr >> 1) & 7)) << 4); }
    f32x16 o0 = {}, o1 = {}, negm = {}; float m = 0.f, lsum = 0.f; bool first = true;
    const int qg = q0 + 32 * wid + r32; const unsigned lds_base = (unsigned)(size_t)lds;
    for (int tp = 0; tp < NT; tp += 2) {
        AT_WAITV(0);
        __builtin_amdgcn_s_barrier(); asm volatile("" ::: "memory");
        if (tp + 2 < NT) { const int sn = 2 * (((tp >> 1) + 1) & 1); AT_ISSUE(tp + 2, sn); AT_ISSUE(tp + 3, sn + 1); }
#pragma unroll 1
      for (int sub = 0; sub < 2; ++sub) {
        const int t = tp + sub, slot = 2 * ((tp >> 1) & 1) + sub;
        const int kv0 = 64 * t;
        if (kv0 <= q0 + 32 * wid + 31) {
            const unsigned sba = lds_base + (unsigned)slot * AT_SLOT;
            bf16x8 kf[12], vf[8];
#define AT_DSR(dst, addr, off) asm volatile("ds_read_b128 %0, %1 offset:%2" : "=v"(dst) : "v"(addr), "i"(off))
#pragma unroll
            for (int s = 0; s < 4; ++s) { const unsigned ka = sba + (unsigned)(kno[0] ^ (s << 5)); AT_DSR(kf[2 * s], ka, 0); AT_DSR(kf[2 * s + 1], ka, 4096); }
#pragma unroll
            for (int s = 0; s < 2; ++s) { const unsigned ka = sba + (unsigned)(kro[0] ^ (s << 5)); AT_DSR(kf[8 + 2 * s], ka, 0); AT_DSR(kf[8 + 2 * s + 1], ka, 2048); }
            f32x16 st0, st1;
#define AT_KSTEP(s, n) do { asm volatile("s_waitcnt lgkmcnt(" #n ")" : "+v"(kf[2 * (s)]), "+v"(kf[2 * (s) + 1])); __builtin_amdgcn_sched_barrier(0); \
                st0 = __builtin_amdgcn_mfma_f32_32x32x16_bf16(kf[2 * (s)], qf[s], st0, 0, 0, 0); st1 = __builtin_amdgcn_mfma_f32_32x32x16_bf16(kf[2 * (s) + 1], qf[s], st1, 0, 0, 0); } while (0)
            { asm volatile("s_waitcnt lgkmcnt(10)" : "+v"(kf[0]), "+v"(kf[1])); __builtin_amdgcn_sched_barrier(0);
              st0 = __builtin_amdgcn_mfma_f32_32x32x16_bf16(kf[0], qf[0], negm, 0, 0, 0); st1 = __builtin_amdgcn_mfma_f32_32x32x16_bf16(kf[1], qf[0], negm, 0, 0, 0); }
            AT_KSTEP(1, 8); AT_KSTEP(2, 6); AT_KSTEP(3, 4); AT_KSTEP(4, 2); AT_KSTEP(5, 0);
            asm volatile("s_nop 15\n\ts_nop 7" : "+v"(st0), "+v"(st1));
#pragma unroll
            for (int ks = 0; ks < 4; ++ks) { const unsigned va = sba + (unsigned)(vto[0] ^ (ks << 5)); AT_DSR(vf[2 * ks], va, 0); AT_DSR(vf[2 * ks + 1], va, 4096); }
            if (kv0 + 63 > q0 + 32 * wid) {
                const int dq = qg - kv0 - 8 * hi;
#pragma unroll
                for (int reg = 0; reg < 16; ++reg) { const int cb = (reg & 3) + 4 * ((reg >> 2) & 1) + 16 * (reg >> 3); if (cb > dq) st0[reg] = -INFINITY; if (cb + 32 > dq) st1[reg] = -INFINITY; }
            }
            float mx = max3f(st0[0], st0[1], st1[0]), mx2 = max3f(st0[2], st0[3], st1[1]); mx = max3f(mx, st1[2], st1[3]);
#pragma unroll
            for (int reg = 4; reg < 16; reg += 4) { mx = max3f(mx, st0[reg], st0[reg + 1]); mx2 = max3f(mx2, st0[reg + 2], st0[reg + 3]); mx = max3f(mx, st1[reg], st1[reg + 1]); mx2 = max3f(mx2, st1[reg + 2], st1[reg + 3]); }
            mx = max3f(mx, mx2, mx2);
            { const auto rr = __builtin_amdgcn_permlane32_swap(__float_as_uint(mx), __float_as_uint(mx), false, false); mx = max3f(__uint_as_float(rr[0]), __uint_as_float(rr[1]), __uint_as_float(rr[1])); }
            if (first || __any(mx > AT_THR)) {
                const float dl = first ? mx : fmaxf(mx, 0.f); const float alpha = first ? 0.f : __builtin_amdgcn_exp2f(-dl); first = false; m += dl; lsum *= alpha;
#pragma unroll
                for (int reg = 0; reg < 16; ++reg) { st0[reg] -= dl; st1[reg] -= dl; o0[reg] *= alpha; o1[reg] *= alpha; negm[reg] = -m; }
            }
            float ps = 0.f;
#pragma unroll
            for (int reg = 0; reg < 16; ++reg) { st0[reg] = __builtin_amdgcn_exp2f(st0[reg]); st1[reg] = __builtin_amdgcn_exp2f(st1[reg]); ps += st0[reg] + st1[reg]; }
            lsum += ps;
            u32x4 pw[4];
#pragma unroll
            for (int q = 0; q < 4; ++q) { pw[0][q] = cvtpk(st0[2 * q], st0[2 * q + 1]); pw[1][q] = cvtpk(st0[8 + 2 * q], st0[8 + 2 * q + 1]); pw[2][q] = cvtpk(st1[2 * q], st1[2 * q + 1]); pw[3][q] = cvtpk(st1[8 + 2 * q], st1[8 + 2 * q + 1]); }
#define AT_VSTEP(ks, n) do { asm volatile("s_waitcnt lgkmcnt(" #n ")" : "+v"(vf[2 * (ks)]), "+v"(vf[2 * (ks) + 1])); __builtin_amdgcn_sched_barrier(0); const bf16x8 pb = __builtin_bit_cast(bf16x8, pw[ks]); \
                o0 = __builtin_amdgcn_mfma_f32_32x32x16_bf16(vf[2 * (ks)], pb, o0, 0, 0, 0); o1 = __builtin_amdgcn_mfma_f32_32x32x16_bf16(vf[2 * (ks) + 1], pb, o1, 0, 0, 0); } while (0)
            AT_VSTEP(0, 6); AT_VSTEP(1, 4); AT_VSTEP(2, 2); AT_VSTEP(3, 0);
#undef AT_DSR
#undef AT_KSTEP
#undef AT_VSTEP
        }
        asm volatile("s_waitcnt lgkmcnt(0)" ::: "memory");
      }
    }
    { const auto rr = __builtin_amdgcn_permlane32_swap(__float_as_uint(lsum), __float_as_uint(lsum), false, false); lsum = __uint_as_float(rr[0]) + __uint_as_float(rr[1]); }
    const float il = 1.0f / lsum; bf16_t* op = MIX + (rowbase + q0 + 32 * wid + r32) * DM + 512 + h * VH;
#pragma unroll
    for (int g = 0; g < 4; ++g) { const int dd = 8 * g + 4 * hi;
        store4bf(op + dd, (f32x4){o0[4 * g] * il, o0[4 * g + 1] * il, o0[4 * g + 2] * il, o0[4 * g + 3] * il});
        store4bf(op + 32 + dd, (f32x4){o1[4 * g] * il, o1[4 * g + 1] * il, o1[4 * g + 2] * il, o1[4 * g + 3] * il}); }
    AT_WAITV(0);
    __builtin_amdgcn_s_barrier(); asm volatile("" ::: "memory");
#undef AT_ISSUE
}
__device__ __forceinline__ void attn_phase(PP p, int wv, int bid, int nb, unsigned char* smem) {
    unsigned char* ws = p->ws;
    const bf16_t* QF = (const bf16_t*)(ws + WS_QF); const bf16_t* KN = (const bf16_t*)(ws + WS_KF); const bf16_t* KR = (const bf16_t*)(ws + WS_KR); const bf16_t* VT = (const bf16_t*)(ws + WS_VT); bf16_t* MIX = (bf16_t*)(ws + WS_MIX);
    const int vcu = (nb % 8 == 0) ? (bid % 8) * (nb / 8) + bid / 8 : bid;
    for (int pr = vcu; pr < BATCH * NH * 8; pr += nb) {
        const int bh = pr >> 3, s = pr & 7;
        attn_unit(wv, bh / NH, bh % NH, 15 - s, QF, KN, KR, VT, MIX, (LAS unsigned char*)smem);
        attn_unit(wv, bh / NH, bh % NH, s, QF, KN, KR, VT, MIX, (LAS unsigned char*)smem);
    }
}

__device__ void router_phase(PP p, int wv, int bid, int nb, unsigned char* smem) {
    const int tid = otid(wv), lane = tid & 63, wid = tid >> 6;
    unsigned char* ws = p->ws; const bf16_t* X = (const bf16_t*)(ws + WS_XB); int* cnt = (int*)(ws + WS_CTL);
    int* TOPE = (int*)(ws + WS_TOPE); float* TOPW = (float*)(ws + WS_TOPW); int* RANK = (int*)(ws + WS_RANK);
    int* se = (int*)smem;
    const float* g = p->norm_ffn + DM; const float* rw = p->router_w;
    f32x4 wlo[4][4], whi[4][4];
#pragma unroll
    for (int j = 0; j < 4; ++j) { const f32x4 gv = *(const f32x4*)(g + 256 * j + 4 * lane);
#pragma unroll
        for (int q = 0; q < 4; ++q) { const float* w = rw + (size_t)(256 * j + 4 * lane + q) * NE; wlo[j][q] = *(const f32x4*)w * gv[q]; whi[j][q] = *(const f32x4*)(w + 4) * gv[q]; } }
    for (int grp = bid; grp < T / 64; grp += nb) {
        for (int i = 0; i < 8; ++i) {
            const int t = grp * 64 + wid * 8 + i; const bf16_t* xr = X + (size_t)t * DM;
            float acc[NE]; float ss = 0.f;
#pragma unroll
            for (int e = 0; e < NE; ++e) acc[e] = 0.f;
            u32x2 xw[4];
#pragma unroll
            for (int j = 0; j < 4; ++j) xw[j] = *(const u32x2*)(xr + 256 * j + 4 * lane);
#pragma unroll
            for (int j = 0; j < 4; ++j) { const f32x4 xv = {bf2f(xw[j].x & 0xffff), bf2f(xw[j].x >> 16), bf2f(xw[j].y & 0xffff), bf2f(xw[j].y >> 16)};
#pragma unroll
                for (int q = 0; q < 4; ++q) { const float xs = xv[q]; ss += xs * xs; const f32x4 w0 = wlo[j][q], w1 = whi[j][q];
                    acc[0] += xs * w0[0]; acc[1] += xs * w0[1]; acc[2] += xs * w0[2]; acc[3] += xs * w0[3]; acc[4] += xs * w1[0]; acc[5] += xs * w1[1]; acc[6] += xs * w1[2]; acc[7] += xs * w1[3]; } }
            ss = wave_sum(ss, lane);
#pragma unroll
            for (int e = 0; e < NE; ++e) acc[e] = wave_sum(acc[e], lane);
            const float rs = rsqrtf(ss * (1.0f / DM) + EPS);
            int e1 = 0; float l1 = acc[0];
#pragma unroll
            for (int e = 1; e < NE; ++e) if (acc[e] > l1) { l1 = acc[e]; e1 = e; }
            int e2 = -1; float l2 = -INFINITY;
#pragma unroll
            for (int e = 0; e < NE; ++e) if (e != e1 && acc[e] > l2) { l2 = acc[e]; e2 = e; }
            const float w2 = 1.f / (1.f + expf((l1 - l2) * rs)), w1 = 1.f - w2;
            if (lane == 0) { ((float*)(ws + WS_RSTOK))[t] = rs; TOPE[2 * t] = e1; TOPE[2 * t + 1] = e2; TOPW[2 * t] = w1; TOPW[2 * t + 1] = w2; se[2 * (wid * 8 + i)] = e1; se[2 * (wid * 8 + i) + 1] = e2; }
        }
        __syncthreads();
        if (wid == 0) {
            const int t = grp * 64 + lane, e1 = se[2 * lane], e2 = se[2 * lane + 1]; int r1 = 0, r2 = 0;
            for (int e = 0; e < NE; ++e) {
                const unsigned long long m1 = __ballot(e1 == e), m2 = __ballot(e2 == e);
                const int c1 = __popcll(m1), c2 = __popcll(m2);
                int base = 0; if (lane == 0 && (c1 + c2) > 0) base = atomicAdd(cnt + e, c1 + c2);
                base = __builtin_amdgcn_readfirstlane(base);
                const unsigned long long below = (lane == 0) ? 0ull : (~0ull >> (64 - lane));
                if (e1 == e) r1 = base + __popcll(m1 & below);
                if (e2 == e) r2 = base + c1 + __popcll(m2 & below);
            }
            RANK[2 * t] = r1; RANK[2 * t + 1] = r2;
        }
        __syncthreads();
    }
}
__device__ void gc_phase(PP p, int wv, int bid, int nb) {
    unsigned char* ws = p->ws; const int* cnt = (const int*)(ws + WS_CTL); int off[NE + 1]; expert_offsets(cnt, off);
    const int* TOPE = (const int*)(ws + WS_TOPE); const float* TOPW = (const float*)(ws + WS_TOPW); const int* RANK = (const int*)(ws + WS_RANK);
    int* rt = (int*)(ws + WS_ROWTOK); float* rw = (float*)(ws + WS_ROWW); int* rs = (int*)(ws + WS_ROWSLOT);
    for (int i = bid * NTHR + otid(wv); i < 2 * T; i += nb * NTHR) {
        const int e = TOPE[i]; int o = 0;
#pragma unroll
        for (int q = 0; q < NE; ++q) if (q == e) o = off[q];
        const int pos = o + RANK[i]; rt[pos] = i >> 1; rw[pos] = TOPW[i]; rs[pos] = i; ((float*)(ws + WS_ROWRS))[pos] = ((const float*)(ws + WS_RSTOK))[i >> 1];
    }
}
__device__ __forceinline__ void egu_phase(PP p, int wv, int bid, int nb, unsigned char* smem) {
    unsigned char* ws = p->ws; const int* cnt = (const int*)(ws + WS_CTL); int off[NE + 1]; expert_offsets(cnt, off);
    pg8::Gemm g{(const bf16_t*)(ws + WS_XB8), (const bf16_t*)(ws + WS_EGU), DM / 2, DM / 2, DM / 2, (const int*)(ws + WS_ROWTOK)};
    pg8::GroupedOrder S; S.so.init(off[NE] / 256, (2 * DFE) / 256, nb, bid); S.o1 = off[1]; S.o2 = off[2]; S.o3 = off[3]; S.o4 = off[4]; S.o5 = off[5]; S.o6 = off[6]; S.o7 = off[7];
    pg8::EpiW<EpiGU<true>> E{EpiGU<true>{(const float*)(ws + WS_ROWRS), nullptr, (bf16_t*)(ws + WS_ACT), DFE}, (2 * DFE) / 256};
    pg8::gemm_phase<pg8::EpiW<EpiGU<true>>, pg8::GroupedOrder, true, true, true>(wv, (PG8_LAS unsigned char*)smem, g, S, E);
}
__device__ __forceinline__ void ed_phase(PP p, int wv, int bid, int nb, unsigned char* smem) {
    unsigned char* ws = p->ws; const int* cnt = (const int*)(ws + WS_CTL); int off[NE + 1]; expert_offsets(cnt, off);
    pg8::Gemm g{(const bf16_t*)(ws + WS_ACT), (const bf16_t*)(ws + WS_ED), DFE / 2, DFE / 2, DFE / 2, nullptr};
    pg8::GroupedOrder S; S.so.init(off[NE] / 256, DM / 256, nb, bid); S.o1 = off[1]; S.o2 = off[2]; S.o3 = off[3]; S.o4 = off[4]; S.o5 = off[5]; S.o6 = off[6]; S.o7 = off[7];
    pg8::EpiW<EpiED> E{EpiED{(const float*)(ws + WS_ROWW), (const int*)(ws + WS_ROWSLOT), (bf16_t*)(ws + WS_Y)}, DM / 256};
    pg8::gemm_phase<pg8::EpiW<EpiED>, pg8::GroupedOrder, true, false, true>(wv, (PG8_LAS unsigned char*)smem, g, S, E);
}
__device__ void final_phase(PP p, int wv, int bid, int nb) {
    const int tid_ = otid(wv); const int lane = tid_ & 63, wid = tid_ >> 6; const bf16_t* Y = (const bf16_t*)(p->ws + WS_Y);
    for (int t = bid * NWAVE + wid; t < T; t += nb * NWAVE) {
        float* xr = p->out + (size_t)t * DM; const bf16_t* xb = (const bf16_t*)(p->ws + WS_XB) + (size_t)t * DM; f32x4 v[4]; u32x2 ya[4], yb[4]; float ss = 0.f;
#pragma unroll
        for (int j = 0; j < 4; ++j) { { const u32x2 xw = __builtin_nontemporal_load((const u32x2*)(xb + 256 * j + 4 * lane)); v[j] = (f32x4){bf2f(xw.x & 0xffff), bf2f(xw.x >> 16), bf2f(xw.y & 0xffff), bf2f(xw.y >> 16)}; }
            ya[j] = __builtin_nontemporal_load((const u32x2*)(Y + (size_t)(2 * t) * DM + 256 * j + 4 * lane)); yb[j] = __builtin_nontemporal_load((const u32x2*)(Y + (size_t)(2 * t + 1) * DM + 256 * j + 4 * lane)); }
#pragma unroll
        for (int j = 0; j < 4; ++j) { const u32x2 a = ya[j], b = yb[j];
            v[j][0] += bf2f(a.x & 0xffff) + bf2f(b.x & 0xffff); v[j][1] += bf2f(a.x >> 16) + bf2f(b.x >> 16); v[j][2] += bf2f(a.y & 0xffff) + bf2f(b.y & 0xffff); v[j][3] += bf2f(a.y >> 16) + bf2f(b.y >> 16);
            ss += (v[j][0] * v[j][0] + v[j][1] * v[j][1]) + (v[j][2] * v[j][2] + v[j][3] * v[j][3]); }
        ss = wave_sum(ss, lane); const float rs = __builtin_amdgcn_rsqf(ss * (1.0f / DM) + EPS);
#pragma unroll
        for (int j = 0; j < 4; ++j) { const f32x4 g = *(const f32x4*)(p->norm_final + 256 * j + 4 * lane); __builtin_nontemporal_store(v[j] * rs * g, (f32x4*)(xr + 256 * j + 4 * lane)); }
    }
}

enum { K_P0, K_GIN, K_LRUSUM, K_GQ, K_GKV, K_ATTN, K_LRUFIN, K_GOUT, K_FUP, K_FDOWN, K_ROUTER, K_GC, K_EGU, K_ED, K_FINAL };
template <int KIND>
__device__ __forceinline__ void run_kind(PP p, int wv, int l, int bid, int nb, unsigned char* smem) {
    unsigned char* ws = p->ws;
    if constexpr (KIND == K_P0) phase_p0(p, wv, bid, nb, smem);
    else if constexpr (KIND == K_GIN) {
        EpiIn E{(const float*)(ws + WS_SSX), (bf16_t*)(ws + WS_XL), (bf16_t*)(ws + WS_GY), (bf16_t*)(ws + WS_CQ), (bf16_t*)(ws + WS_KR), (float*)(ws + WS_SSQ), (float*)(ws + WS_SSKV), (const float*)(ws + WS_TAB)};
        gemm_static<EpiIn, true>(wv, (const bf16_t*)(ws + WS_XB), DM, (const bf16_t*)(ws + WS_WIN) + (size_t)l * INCP * DM, DM, T, INCP, DM, E, bid, nb, smem);
    } else if constexpr (KIND == K_LRUSUM) lru_sum_phase(p, wv, l, bid, nb, smem);
    else if constexpr (KIND == K_GQ) {
        EpiQ EQ{(const float*)(ws + WS_SSQ), (bf16_t*)(ws + WS_QF), (const float*)(ws + WS_TAB)};
        gemm_static<EpiQ, true>(wv, (const bf16_t*)(ws + WS_CQ), 384, (const bf16_t*)(ws + WS_WUQ) + (size_t)l * QW * QLORA, QLORA, T, QW, QLORA, EQ, bid, nb, smem);
    } else if constexpr (KIND == K_GKV) {
        EpiKV EK{(const float*)(ws + WS_SSKV), (bf16_t*)(ws + WS_KF), (bf16_t*)(ws + WS_VT)};
        gemm_static<EpiKV, true>(wv, (const bf16_t*)(ws + WS_CQ) + 128, 384, (const bf16_t*)(ws + WS_WUKV) + (size_t)l * KVW * 256, 256, T, KVW, 256, EK, bid, nb, smem);
    } else if constexpr (KIND == K_ATTN) attn_phase(p, wv, bid, nb, smem);
    else if constexpr (KIND == K_LRUFIN) lru_scan_phase(p, wv, bid, nb);
    else if constexpr (KIND == K_GOUT) {
        EpiRes E{(bf16_t*)(ws + WS_XB), l == 1 ? ws + WS_XB8 : nullptr, (float*)(ws + WS_SSX), 1.0f};
        gemm_static<EpiRes, true>(wv, (const bf16_t*)(ws + WS_MIX), DM, (const bf16_t*)(ws + WS_WOUT) + (size_t)l * DM * DM, DM, T, DM, DM, E, bid, nb, smem);
    } else if constexpr (KIND == K_FUP) {
        EpiGU<false, true> E{(const float*)(ws + WS_SSX), nullptr, (bf16_t*)(ws + WS_ACT), DFF};
        gemm_static<EpiGU<false, true>, true>(wv, (const bf16_t*)(ws + WS_XB), DM, (const bf16_t*)(ws + WS_WGU), DM, T, 2 * DFF, DM, E, bid, nb, smem);
    } else if constexpr (KIND == K_FDOWN) {
        EpiRes E{(bf16_t*)(ws + WS_XB), nullptr, (float*)(ws + WS_SSX), 1.0f / (F8_AS * F8_WS)};
        gemm_static<EpiRes, true, true>(wv, (const bf16_t*)(ws + WS_ACT), DFF / 2, (const bf16_t*)(ws + WS_WD), DFF / 2, T, DM, DFF / 2, E, bid, nb, smem);
    } else if constexpr (KIND == K_ROUTER) router_phase(p, wv, bid, nb, smem);
    else if constexpr (KIND == K_GC) gc_phase(p, wv, bid, nb);
    else if constexpr (KIND == K_EGU) egu_phase(p, wv, bid, nb, smem);
    else if constexpr (KIND == K_ED) ed_phase(p, wv, bid, nb, smem);
    else final_phase(p, wv, bid, nb);
}

constexpr int LDS_BYTES = 163840;
template <int KIND>
__global__ void __launch_bounds__(NTHR) k_phase(P p, int l) {
    extern __shared__ __attribute__((aligned(16))) unsigned char smem[];
    run_kind<KIND>((PP)__builtin_amdgcn_kernarg_segment_ptr(), __builtin_amdgcn_readfirstlane((int)threadIdx.x >> 6), l, (int)blockIdx.x, (int)gridDim.x, smem);
}
template <int KIND> static void launch_kind(PP p, int l, int grid, hipStream_t stream) {
    static bool attr = false;
    if (!attr) { (void)hipFuncSetAttribute((const void*)k_phase<KIND>, hipFuncAttributeMaxDynamicSharedMemorySize, LDS_BYTES); attr = true; }
    hipLaunchKernelGGL(k_phase<KIND>, dim3(grid), dim3(NTHR), LDS_BYTES, stream, p, l);
}

#define XB_TMO      128
#define XB_XCNT(j)  (256  + 64 * (j))
#define XB_XSUB(j)  (1280 + 64 * (j))
#define XB_XGEN(j)  (2304 + 64 * (j))
#define XB_TOP      3328
#define XB_TOPGEN   3392
#define XCD_BAR_WORDS 3456
#define XB_SPIN_CAP (1u << 18)

__device__ __forceinline__ unsigned xb_ld(unsigned* p)              { return __hip_atomic_load(p, __ATOMIC_RELAXED, __HIP_MEMORY_SCOPE_AGENT); }
__device__ __forceinline__ unsigned xb_add(unsigned* p, unsigned v) { return __hip_atomic_fetch_add(p, v, __ATOMIC_RELAXED, __HIP_MEMORY_SCOPE_AGENT); }
__device__ __forceinline__ unsigned xb_xcc_id() { return (unsigned)__builtin_amdgcn_s_getreg((3 << 11) | 20) & 0xFu; }
#define XB_SPIN(cond, bar) do { unsigned _sp = 0; while (cond) { __builtin_amdgcn_s_sleep(1); \
    if ((++_sp & 255u) == 0u) { if (xb_ld(&(bar)[XB_TMO])) break; if (_sp > XB_SPIN_CAP) { atomicAdd(&(bar)[XB_TMO], 1u); break; } } } } while (0)

struct XcdBarrier {
    unsigned* bar; unsigned x;
    volatile LAS unsigned* st;
};

__device__ __forceinline__ XcdBarrier xcd_barrier_post(unsigned* bar, volatile LAS unsigned* st, bool leader) {
    XcdBarrier b; b.bar = bar; b.x = xb_xcc_id(); b.st = st;
    if (leader) (void)xb_add(&bar[XB_XCNT(b.x)], 1u);
    return b;
}
__device__ __forceinline__ void xcd_barrier_complete(unsigned* bar, unsigned x, unsigned& nloc, unsigned& nx) {
    const unsigned G = gridDim.x * gridDim.y * gridDim.z;
    unsigned sum, cnt, mine, sp = 0u;
    for (;;) {
        sum = 0u; cnt = 0u; mine = 0u;
#pragma unroll
        for (unsigned j = 0; j < 16; ++j) { const unsigned c = xb_ld(&bar[XB_XCNT(j)]); sum += c; cnt += (c > 0u) ? 1u : 0u; mine = (j == x) ? c : mine; }
        if (sum == G) break;
        __builtin_amdgcn_s_sleep(1);
        if ((++sp & 255u) == 0u) { if (xb_ld(&bar[XB_TMO])) break; if (sp > XB_SPIN_CAP) { atomicAdd(&bar[XB_TMO], 1u); break; } }
    }
    nloc = mine > 0u ? mine : 1u; nx = cnt > 0u ? cnt : 1u;
}

__device__ __forceinline__ void xcd_barrier(const XcdBarrier& b, bool leader) {
    asm volatile("s_waitcnt vmcnt(0)" ::: "memory");
    __syncthreads();
    if (leader) {
        unsigned* bar = b.bar;
        __builtin_amdgcn_s_waitcnt(0);
        unsigned nloc = b.st[0], nx = b.st[1];
        if (nloc == 0u) { xcd_barrier_complete(bar, b.x, nloc, nx); b.st[0] = nloc; b.st[1] = nx; }
        const unsigned old = xb_add(&bar[XB_XSUB(b.x)], 1u);
        const unsigned gen = old / nloc;
        if (old + 1u == (gen + 1u) * nloc) {
            __builtin_amdgcn_fence(__ATOMIC_RELEASE, "agent");
            asm volatile("s_waitcnt vmcnt(0)" ::: "memory");
            const unsigned og = xb_add(&bar[XB_TOP], 1u);
            const unsigned tg = og / nx;
            if (og + 1u == (tg + 1u) * nx) xb_add(&bar[XB_TOPGEN], 1u);
            else XB_SPIN(xb_ld(&bar[XB_TOPGEN]) == tg, bar);
            __builtin_amdgcn_fence(__ATOMIC_ACQUIRE, "agent");
            xb_add(&bar[XB_XGEN(b.x)], 1u);
            asm volatile("s_waitcnt vmcnt(0)" ::: "memory");
        } else {
            XB_SPIN(xb_ld(&bar[XB_XGEN(b.x)]) == gen, bar);
            __builtin_amdgcn_fence(__ATOMIC_ACQUIRE, "agent");
            asm volatile("s_waitcnt vmcnt(0)" ::: "memory");
        }
    }
    __syncthreads();
}


#if MK_MODE != 0
__global__ void __launch_bounds__(NTHR) mk_fused(P p_arg) {
    extern __shared__ __attribute__((aligned(16))) unsigned char smem[];
    const int bid0 = (int)blockIdx.x, nb0 = (int)gridDim.x;
    const PP kp = (PP)__builtin_amdgcn_kernarg_segment_ptr();
    const int wv = __builtin_amdgcn_readfirstlane((int)threadIdx.x >> 6);
    volatile LAS unsigned* misc = (volatile LAS unsigned*)((LAS unsigned char*)smem + MISC_OFF);
    if (threadIdx.x < 64) misc[threadIdx.x] = 0u;
    __syncthreads();
    (void)xcd_barrier_post((unsigned*)(kp->ws + WS_CTL) + CW_BAR, misc + 8, threadIdx.x == 0);
#define GRID_BAR() do { PP kq_ = kp; asm volatile("" : "+s"(kq_)); XcdBarrier b_; b_.bar = (unsigned*)(kq_->ws + WS_CTL) + CW_BAR; b_.x = xb_xcc_id(); b_.st = (volatile LAS unsigned*)((LAS unsigned char*)smem + MISC_OFF) + 8; \
        xcd_barrier(b_, otid(wv) == 0); } while (0)
#ifndef PROBE_DUP
#define PROBE_DUP -1
#endif
#define DUP(k, stmt) do { PP p = kp; int bid = bid0, nb = nb0; asm volatile("" : "+s"(p), "+s"(bid), "+s"(nb)); stmt; if (PROBE_DUP == (k)) { GRID_BAR(); stmt; } } while (0)
    DUP(0, run_kind<K_P0>(p, wv, 0, bid, nb, smem)); GRID_BAR();
#pragma unroll 1
    for (int l = 0; l < DEPTH; ++l) {
        DUP(1, run_kind<K_GIN>(p, wv, l, bid, nb, smem)); GRID_BAR();
        DUP(2, run_kind<K_LRUSUM>(p, wv, l, bid, nb, smem)); __syncthreads(); DUP(3, run_kind<K_GQ>(p, wv, l, bid, nb, smem)); __syncthreads(); DUP(4, run_kind<K_GKV>(p, wv, l, bid, nb, smem)); GRID_BAR();
        DUP(5, run_kind<K_ATTN>(p, wv, l, bid, nb, smem)); __syncthreads(); DUP(6, run_kind<K_LRUFIN>(p, wv, l, bid, nb, smem)); GRID_BAR();
        DUP(-2, run_kind<K_GOUT>(p, wv, l, bid, nb, smem)); GRID_BAR();
        if (l == 0) { DUP(7, run_kind<K_FUP>(p, wv, l, bid, nb, smem)); GRID_BAR(); DUP(-2, run_kind<K_FDOWN>(p, wv, l, bid, nb, smem)); GRID_BAR(); }
    }
    DUP(-2, run_kind<K_ROUTER>(p, wv, 1, bid, nb, smem)); GRID_BAR();
    DUP(8, run_kind<K_GC>(p, wv, 1, bid, nb, smem)); GRID_BAR();
    DUP(9, run_kind<K_EGU>(p, wv, 1, bid, nb, smem)); GRID_BAR();
    DUP(10, run_kind<K_ED>(p, wv, 1, bid, nb, smem)); GRID_BAR();
    DUP(-2, run_kind<K_FINAL>(p, wv, 1, bid, nb, smem));
#undef DUP
#undef GRID_BAR
}

#endif
extern "C" void kernel_launch(void* const* d_in, const int* in_sizes, int n_in, void* d_out, int out_size, void* d_ws, size_t ws_size, hipStream_t stream) {
    if (n_in != 25 || out_size != T * DM || ws_size < WS_END) { fprintf(stderr, "kernel_launch: unexpected shapes (n_in %d, out %d, ws %zu)\n", n_in, out_size, ws_size); return; }
    P p{};
    p.x = (const float*)d_in[0]; p.positions = (const int*)d_in[1]; p.norm_mix = (const float*)d_in[2]; p.w_in = (const float*)d_in[3]; p.conv_w = (const float*)d_in[4]; p.conv_b = (const float*)d_in[5];
    p.lru_wa = (const float*)d_in[6]; p.lru_ba = (const float*)d_in[7]; p.lru_wx = (const float*)d_in[8]; p.lru_bx = (const float*)d_in[9]; p.lru_lambda = (const float*)d_in[10]; p.q_norm = (const float*)d_in[11];
    p.w_uq = (const float*)d_in[12]; p.kv_norm = (const float*)d_in[13]; p.w_ukv = (const float*)d_in[14]; p.w_out = (const float*)d_in[15]; p.norm_ffn = (const float*)d_in[16];
    p.dense_w_gate = (const float*)d_in[17]; p.dense_w_up = (const float*)d_in[18]; p.dense_w_down = (const float*)d_in[19]; p.router_w = (const float*)d_in[20];
    p.expert_w_gate = (const float*)d_in[21]; p.expert_w_up = (const float*)d_in[22]; p.expert_w_down = (const float*)d_in[23]; p.norm_final = (const float*)d_in[24];
    p.out = (float*)d_out; p.ws = (unsigned char*)d_ws;
#if MK_MODE == 0
    const int G = 1024;
    launch_kind<K_P0>(p, 0, G, stream);
    for (int l = 0; l < DEPTH; ++l) {
        launch_kind<K_GIN>(p, l, G, stream);
        launch_kind<K_LRUSUM>(p, l, 256, stream); launch_kind<K_GQ>(p, l, G, stream); launch_kind<K_GKV>(p, l, G, stream);
        launch_kind<K_ATTN>(p, l, G, stream); launch_kind<K_LRUFIN>(p, l, 256, stream);
        launch_kind<K_GOUT>(p, l, G, stream);
        if (l == 0) { launch_kind<K_FUP>(p, l, G, stream); launch_kind<K_FDOWN>(p, l, G, stream); }
        else { launch_kind<K_ROUTER>(p, l, 256, stream); launch_kind<K_GC>(p, l, 64, stream); launch_kind<K_EGU>(p, l, G, stream); launch_kind<K_ED>(p, l, G, stream); launch_kind<K_FINAL>(p, l, G, stream); }
    }
#else
    static int grid_blocks = 0;
    if (!grid_blocks) {
        int dev = 0, cus = 0, per_cu = 0;
        (void)hipGetDevice(&dev); (void)hipDeviceGetAttribute(&cus, hipDeviceAttributeMultiprocessorCount, dev);
        (void)hipFuncSetAttribute((const void*)mk_fused, hipFuncAttributeMaxDynamicSharedMemorySize, LDS_BYTES);
        (void)hipOccupancyMaxActiveBlocksPerMultiprocessor(&per_cu, (const void*)mk_fused, NTHR, LDS_BYTES);
        if (per_cu < 1) { fprintf(stderr, "kernel_launch: occupancy query says %d blocks/CU\n", per_cu); per_cu = 1; }
        grid_blocks = cus * 1;
    }
    (void)hipMemsetAsync((char*)d_ws + WS_CTL, 0, CTL_ZERO_BYTES, stream);
    void* args[] = {&p};
    hipError_t e = hipLaunchCooperativeKernel((const void*)mk_fused, dim3(grid_blocks), dim3(NTHR), args, LDS_BYTES, stream);
    if (e != hipSuccess) fprintf(stderr, "cooperative launch failed: %s (grid %d)\n", hipGetErrorString(e), grid_blocks);
#endif
}
```

```cpp
#include <hip/hip_runtime.h>
#include <hip/hip_cooperative_groups.h>
#include <cstdint>
#include <cstdio>
namespace cg = cooperative_groups;
#ifndef MK_MODE
#define MK_MODE 1
#endif

#define LAS __attribute__((address_space(3)))
typedef unsigned short bf16_t;
typedef short bf16x8 __attribute__((ext_vector_type(8)));
typedef float f32x4 __attribute__((ext_vector_type(4)));
typedef float f32x16 __attribute__((ext_vector_type(16)));
typedef unsigned u32x4 __attribute__((ext_vector_type(4)));
typedef unsigned u32x2 __attribute__((ext_vector_type(2)));
typedef float f32x2_t __attribute__((ext_vector_type(2)));

constexpr int BATCH = 4, SEQ = 4096, T = BATCH * SEQ, DM = 1024, DEPTH = 2;
constexpr int LRU_W = 512, NH = 8, QKN = 64, QKR = 32, VH = 64, QLORA = 256, KVLORA = 128;
constexpr int INC = 1440, INCP = 1536, DQK = QKN + QKR  , QW = NH * DQK  , KVW = NH * (QKN + VH)  ;
constexpr int DFF = 2816, NE = 8, DFE = 1792;
constexpr float EPS = 1e-6f;
constexpr int NTHR = 512, NWAVE = 8;
constexpr int ROWS_MAX = 2 * T + NE * 256;
constexpr float QSCALE = 0.10206207261596577f * 1.4426950408889634f;

constexpr size_t MiB = 1u << 20;
constexpr size_t WS_CTL = 0;
constexpr size_t WS_TAB = 1 * MiB;
constexpr size_t WS_SSX = 3 * MiB;
constexpr size_t WS_SSQ = 5 * MiB;
constexpr size_t WS_SSKV = 5 * MiB + 512 * 1024;
constexpr size_t WS_SUM = 6 * MiB;
constexpr size_t WS_TOPE = 7 * MiB;
constexpr size_t WS_TOPW = WS_TOPE + 128 * 1024;
constexpr size_t WS_RANK = WS_TOPW + 128 * 1024;
constexpr size_t WS_ROWTOK = WS_RANK + 128 * 1024;
constexpr size_t WS_ROWW = WS_ROWTOK + 136 * 1024;
constexpr size_t WS_ROWSLOT = WS_ROWW + 136 * 1024;
constexpr size_t WS_RSTOK = WS_ROWSLOT + 136 * 1024;
constexpr size_t WS_ROWRS = WS_RSTOK + 64 * 1024;
constexpr size_t WS_LW = 5 * MiB + 768 * 1024;
constexpr size_t WS_WIN = 8 * MiB;
constexpr size_t WS_WUQ = 14 * MiB;
constexpr size_t WS_WUKV = 15 * MiB;
constexpr size_t WS_WOUT = 16 * MiB;
constexpr size_t WS_WGU = 20 * MiB;
constexpr size_t WS_WD = 31 * MiB;
constexpr size_t WS_XB = 37 * MiB;
constexpr size_t WS_EGU = 84 * MiB;
constexpr size_t WS_ED = 69 * MiB;
constexpr size_t WS_LAU = 116 * MiB;
constexpr size_t WS_SP8 = 116 * MiB;
constexpr size_t WS_Y = 84 * MiB;
constexpr size_t WS_XB8 = 216 * MiB;
constexpr size_t WS_ACT = 153 * MiB;
constexpr size_t WS_XL = 153 * MiB, WS_GY = 169 * MiB, WS_QF = 185 * MiB, WS_KF = 209 * MiB, WS_VT = 233 * MiB;
constexpr size_t WS_CQ = 185 * MiB  , WS_KR = 225 * MiB  , WS_MIX = 249 * MiB;
constexpr size_t WS_CQF = 197 * MiB;
constexpr size_t WS_RTF = 281 * MiB, WS_RWF = WS_RTF + 512 * 1024, WS_RSF = WS_RWF + 512 * 1024, WS_RRSF = WS_RSF + 512 * 1024;
constexpr size_t WS_END = 283 * MiB;

constexpr int MISC_OFF = 163840 - 256;
constexpr int CW_BAR = 4096;
constexpr size_t CTL_ZERO_BYTES = 65536;
struct P {
    const float *x; const int* positions; const float *norm_mix, *w_in, *conv_w, *conv_b, *lru_wa, *lru_ba, *lru_wx, *lru_bx, *lru_lambda, *q_norm, *w_uq, *kv_norm, *w_ukv,
        *w_out, *norm_ffn, *dense_w_gate, *dense_w_up, *dense_w_down, *router_w, *expert_w_gate, *expert_w_up, *expert_w_down, *norm_final;
    float* out; unsigned char* ws;
};
typedef const __attribute__((address_space(4))) P* PP;

__device__ __forceinline__ int otid(int wv) { int t = (wv << 6) | (int)__builtin_amdgcn_mbcnt_hi(~0u, __builtin_amdgcn_mbcnt_lo(~0u, 0u)); asm volatile("" : "+v"(t)); return t; }
typedef __bf16 bf16x2_t __attribute__((ext_vector_type(2)));
__device__ __forceinline__ unsigned pk2(float lo, float hi) { f32x2_t v = {lo, hi}; bf16x2_t b = __builtin_convertvector(v, bf16x2_t); return __builtin_bit_cast(unsigned, b); }
__device__ __forceinline__ unsigned f2bf(float f) { return pk2(f, 0.f) & 0xffffu; }
__device__ __forceinline__ float bf2f(unsigned short b) { return __builtin_bit_cast(float, (unsigned)b << 16); }
constexpr float F8_WS = 256.f, F8_XS = 8.f, F8_AS = 16.f, F8_YS = 32.f;
__device__ __forceinline__ unsigned pk4_fp8(float a, float b, float c, float d) {
    a = fminf(fmaxf(a, -448.f), 448.f); b = fminf(fmaxf(b, -448.f), 448.f); c = fminf(fmaxf(c, -448.f), 448.f); d = fminf(fmaxf(d, -448.f), 448.f);
    unsigned w = 0u; w = __builtin_amdgcn_cvt_pk_fp8_f32(a, b, w, false); w = __builtin_amdgcn_cvt_pk_fp8_f32(c, d, w, true); return w; }
__device__ __forceinline__ void store4bf(bf16_t* p, f32x4 v) { u32x2 w; w.x = pk2(v[0], v[1]); w.y = pk2(v[2], v[3]); *(u32x2*)p = w; }
__device__ __forceinline__ void store8bf_x(bf16_t* p, int col, f32x4 v0, f32x4 v1) {
    const auto rx = __builtin_amdgcn_permlane16_swap(pk2(v0[0], v0[1]), pk2(v1[0], v1[1]), false, false), ry = __builtin_amdgcn_permlane16_swap(pk2(v0[2], v0[3]), pk2(v1[2], v1[3]), false, false);
    *(u32x4*)((col & 4) ? p + 12 : p) = (u32x4){rx[0], ry[0], rx[1], ry[1]};
}
__device__ __forceinline__ void store4bf_x(bf16_t* p, int col, f32x4 v) {
    const unsigned ax = pk2(v[0], v[1]), ay = pk2(v[2], v[3]);
    const auto rx = __builtin_amdgcn_permlane16_swap(ax, ax, false, false), ry = __builtin_amdgcn_permlane16_swap(ay, ay, false, false);
    if (!(col & 4)) *(u32x4*)p = (u32x4){rx[0], ry[0], rx[1], ry[1]};
}
__device__ __forceinline__ float sigmoidf_(float x) { return __builtin_amdgcn_rcpf(1.f + __builtin_amdgcn_exp2f(-1.4426950408889634f * x)); }
__device__ __forceinline__ float gelu_tanh(float x) { const float u = 0.7978845608028654f * (x + 0.044715f * x * x * x); return x * sigmoidf_(2.0f * u); }
__device__ __forceinline__ float fq_sum(float s) {
    { const auto r = __builtin_amdgcn_permlane16_swap(__float_as_uint(s), __float_as_uint(s), false, false); s = __uint_as_float(r[0]) + __uint_as_float(r[1]); }
    { const auto r = __builtin_amdgcn_permlane32_swap(__float_as_uint(s), __float_as_uint(s), false, false); s = __uint_as_float(r[0]) + __uint_as_float(r[1]); }
    return s; }
__device__ __forceinline__ float shfl_xor_l(float v, int lane, int mask) { return __builtin_bit_cast(float, __builtin_amdgcn_ds_bpermute((lane ^ mask) << 2, __builtin_bit_cast(int, v))); }
__device__ __forceinline__ float wave_sum(float v, int lane) {
#pragma unroll
    for (int o = 1; o < 64; o <<= 1) v += shfl_xor_l(v, lane, o);
    return v;
}
__device__ __forceinline__ float row_rs(const float* ss, int row, int nslot, float inv_n) {
    float s = 0.f;
    for (int i = 0; i < nslot; i += 4) { const f32x4 v = *(const f32x4*)(ss + (size_t)row * nslot + i); s += (v[0] + v[1]) + (v[2] + v[3]); }
    return rsqrtf(s * inv_n + EPS);
}

constexpr int NMAT = 4 * DEPTH + 2 * 8 * DEPTH + 3 + 3 * NE;
struct MatDesc { const float* src; bf16_t* dst; const float* gain; int K, N, ldk, koff, mode, start, f8; float scale; };
__device__ __forceinline__ void get_mat(PP p, int m, MatDesc& d) {
    unsigned char* ws = p->ws; d.gain = nullptr; d.mode = 0; d.koff = 0; d.start = 0; d.f8 = 0; d.scale = 1.0f;
    if (m < 4 * DEPTH) { const int l = m >> 2, w = m & 3;
        if (w == 0) { d.src = p->w_in + (size_t)l * DM * INC; d.K = DM; d.N = INC; d.dst = (bf16_t*)(ws + WS_WIN) + (size_t)l * INCP * DM; d.gain = p->norm_mix + l * DM; d.ldk = DM; }
        else if (w == 1) { d.src = p->w_uq + (size_t)l * QLORA * QW; d.K = QLORA; d.N = QW; d.dst = (bf16_t*)(ws + WS_WUQ) + (size_t)l * QW * QLORA; d.gain = p->q_norm + l * QLORA; d.ldk = QLORA; d.mode = 3; }
        else if (w == 2) { d.src = p->w_ukv + (size_t)l * KVLORA * KVW; d.K = KVLORA; d.N = KVW; d.dst = (bf16_t*)(ws + WS_WUKV) + (size_t)l * KVW * 256; d.gain = p->kv_norm + l * KVLORA; d.ldk = 256; d.koff = 128; }
        else { d.src = p->w_out + (size_t)l * DM * DM; d.K = DM; d.N = DM; d.dst = (bf16_t*)(ws + WS_WOUT) + (size_t)l * DM * DM; d.ldk = DM; }
        return; }
    m -= 4 * DEPTH;
    if (m < 2 * 8 * DEPTH) { const int q = m >> 1, w = m & 1; d.src = (w ? p->lru_wx : p->lru_wa) + (size_t)q * 4096; d.K = 64; d.N = 64; d.dst = (bf16_t*)(ws + WS_LW) + (size_t)(q * 2 + w) * 4096; d.ldk = 64; d.scale = -1.4426950408889634f; return; }
    m -= 2 * 8 * DEPTH;
    if (m < 3) {
        if (m == 0) { d.src = p->dense_w_gate; d.K = DM; d.N = DFF; d.dst = (bf16_t*)(ws + WS_WGU); d.gain = p->norm_ffn; d.ldk = DM; d.mode = 1; }
        else if (m == 1) { d.src = p->dense_w_up; d.K = DM; d.N = DFF; d.dst = (bf16_t*)(ws + WS_WGU); d.gain = p->norm_ffn; d.ldk = DM; d.mode = 2; }
        else { d.src = p->dense_w_down; d.K = DFF; d.N = DM; d.dst = (bf16_t*)(ws + WS_WD); d.ldk = DFF; }
        return; }
    m -= 3;
    { const int e = m / 3, w = m % 3;
      d.f8 = 1;
      if (w == 0) { d.src = p->expert_w_gate + (size_t)e * DM * DFE; d.K = DM; d.N = DFE; d.dst = (bf16_t*)(ws + WS_EGU + (size_t)e * 2 * DFE * DM); d.gain = p->norm_ffn + DM; d.ldk = DM; d.mode = 1; }
      else if (w == 1) { d.src = p->expert_w_up + (size_t)e * DM * DFE; d.K = DM; d.N = DFE; d.dst = (bf16_t*)(ws + WS_EGU + (size_t)e * 2 * DFE * DM); d.gain = p->norm_ffn + DM; d.ldk = DM; d.mode = 2; }
      else { d.src = p->expert_w_down + (size_t)e * DFE * DM; d.K = DFE; d.N = DM; d.dst = (bf16_t*)(ws + WS_ED + (size_t)e * DM * DFE); d.ldk = DFE; } }
}

__device__ void phase_p0(PP p, int wv, int bid, int nb, unsigned char* smem) {
    const int tid = otid(wv), lane = tid & 63, wid = tid >> 6;
    const int gw = bid * NWAVE + wid, ngw = nb * NWAVE;
    unsigned char* ws = p->ws;
    MatDesc* tabm = (MatDesc*)smem;
    if (tid < NMAT) { MatDesc d; get_mat(p, tid, d); const int ksh = d.f8 ? 2 : 1; d.start = (d.K >> (5 + ksh)) * ((d.N + (256 >> ksh) - 1) / (256 >> ksh)); tabm[tid] = d; }
    __syncthreads();
    if (tid == 0) { int acc = 0; for (int m = 0; m < NMAT; ++m) { const int n = tabm[m].start; tabm[m].start = acc; acc += n; } ((int*)(tabm + NMAT))[0] = acc; }
    __syncthreads();
    const int total = ((const int*)(tabm + NMAT))[0];
    for (int item = gw; item < total; item += ngw) {
        int lo = 0, hi = NMAT - 1;
        while (lo < hi) { const int mid = (lo + hi + 1) >> 1; if (tabm[mid].start <= item) lo = mid; else hi = mid - 1; }
        const MatDesc d = tabm[lo];
        const int ksh = d.f8 ? 2 : 1, nw = 256 >> ksh, local = item - d.start, nbn = (d.N + nw - 1) / nw, kb = local / nbn, nbk = local % nbn, k0 = (32 << ksh) * kb + 32 * (lane & ((1 << ksh) - 1)), n0 = nw * nbk + 4 * (lane >> ksh);
        if (n0 < d.N) {
            f32x4 v[32];
#pragma unroll
            for (int j = 0; j < 32; ++j) v[j] = __builtin_nontemporal_load((const f32x4*)(d.src + (size_t)(k0 + j) * d.N + n0));
            if (d.gain) {
#pragma unroll
                for (int j = 0; j < 32; ++j) v[j] *= d.gain[k0 + j];
            }
            if (d.scale != 1.0f) {
#pragma unroll
                for (int j = 0; j < 32; ++j) v[j] *= d.scale;
            }
#pragma unroll
            for (int e = 0; e < 4; ++e) { const int n = n0 + e; const int drow = d.mode == 0 ? n : ((n >> 4) * 32 + (n & 15) + (d.mode == 2 ? 16 : 0));
                if (d.f8) { unsigned char* dp8 = (unsigned char*)d.dst + (size_t)drow * d.ldk + k0;
#pragma unroll
                    for (int q = 0; q < 2; ++q) { u32x4 o;
#pragma unroll
                        for (int r = 0; r < 4; ++r) o[r] = pk4_fp8(v[16 * q + 4 * r][e] * F8_WS, v[16 * q + 4 * r + 1][e] * F8_WS, v[16 * q + 4 * r + 2][e] * F8_WS, v[16 * q + 4 * r + 3][e] * F8_WS);
                        *(u32x4*)(dp8 + 16 * q) = o; } }
                else { bf16_t* dp = d.dst + (size_t)drow * d.ldk + d.koff + k0;
                  const int hq = n / DQK, rq = n % DQK, dl = rq & 31, pil = (dl & 0x13) | ((dl & 4) << 1) | ((dl & 8) >> 1);
#pragma unroll
                for (int q = 0; q < 4; ++q) { u32x4 o; o.x = pk2(v[8 * q][e], v[8 * q + 1][e]); o.y = pk2(v[8 * q + 2][e], v[8 * q + 3][e]); o.z = pk2(v[8 * q + 4][e], v[8 * q + 5][e]); o.w = pk2(v[8 * q + 6][e], v[8 * q + 7][e]);
                    if (d.mode == 3) { const int k = k0 + 8 * q; *(u32x4*)(d.dst + ((size_t)(((hq * 3 + (rq >> 5)) * 16 + (k >> 4)) * 64 + ((k >> 3) & 1) * 32 + pil)) * 8) = o; }
                    else *(u32x4*)(dp + 8 * q) = o; } } }
        }
    }
    const int gt = bid * NTHR + tid, ngt = nb * NTHR;
    for (int l = 0; l < DEPTH; ++l) { u32x4* z = (u32x4*)((bf16_t*)(ws + WS_WIN) + ((size_t)l * INCP + INC) * DM); for (int i = gt; i < (INCP - INC) * DM / 8; i += ngt) z[i] = (u32x4){0u, 0u, 0u, 0u}; }
    for (int l = 0; l < DEPTH; ++l) { bf16_t* wk = (bf16_t*)(ws + WS_WUKV) + (size_t)l * KVW * 256; for (int i = gt; i < KVW * 16; i += ngt) *(u32x4*)(wk + (size_t)(i >> 4) * 256 + (i & 15) * 8) = (u32x4){0u, 0u, 0u, 0u}; }
    { float* tab = (float*)(ws + WS_TAB);
      for (int i = gt; i < T * 16; i += ngt) { const int t = i >> 4, f = i & 15; const float inv = 1.0f / powf(10000.0f, (float)f / 16.0f); const float ang = (float)p->positions[t] * inv;
          float s, c; sincosf(ang, &s, &c); tab[2 * i] = c; tab[2 * i + 1] = s; } }
    { float* st = (float*)(ws + WS_SP8); for (int i = gt; i < DEPTH * LRU_W; i += ngt) st[i] = -8.0f * 1.4426950408889634f * log1pf(expf(-p->lru_lambda[i])); }
    { int* cnt = (int*)(ws + WS_CTL); if (gt < 64) cnt[gt] = 0;
      int* rt = (int*)(ws + WS_RTF); float* rw = (float*)(ws + WS_RWF); int* rs = (int*)(ws + WS_RSF); float* rrs = (float*)(ws + WS_RRSF);
      for (int i = gt; i < NE * T; i += ngt) { rt[i] = 0; rw[i] = 0.f; rs[i] = -1; rrs[i] = 0.f; } }
    { bf16_t* XB = (bf16_t*)(ws + WS_XB); float* ssx = (float*)(ws + WS_SSX);
      for (int r = 2 * gw; r < T; r += 2 * ngw) {
          const f32x4* xr = (const f32x4*)(p->x + (size_t)r * DM) + lane; f32x4 v[8];
#pragma unroll
          for (int j = 0; j < 8; ++j) v[j] = __builtin_nontemporal_load(xr + 64 * j);
#pragma unroll
          for (int j = 0; j < 8; ++j) { const int rr = r + (j >> 2), jj = j & 3; store4bf(XB + (size_t)rr * DM + 256 * jj + 4 * lane, v[j]);
              float s = (v[j][0] * v[j][0] + v[j][1] * v[j][1]) + (v[j][2] * v[j][2] + v[j][3] * v[j][3]); s += shfl_xor_l(s, lane, 1); s += shfl_xor_l(s, lane, 2); s += shfl_xor_l(s, lane, 4);
              if ((lane & 7) == 0) ssx[(size_t)rr * 32 + 8 * jj + (lane >> 3)] = s; } } }
}

namespace pg8 {
#define PG8_LAS __attribute__((address_space(3)))
constexpr int BM = 256, BK = 64, HALF = 128, HTB = HALF * BK * 2, STAGE_BYTES = 8 * HTB, NXCD = 8, WGM = 8;
__host__ __device__ __forceinline__ int lds_byte(int r, int c) { const int st = (r >> 4) * 2 + (c >> 5), rr = r & 15, cc = c & 31, ob = rr * 64 + cc * 2; return st * 1024 + (ob ^ (((ob >> 9) & 1) << 5)); }
__host__ __device__ __forceinline__ void stage_rc(int b, int& R, int& C) { const int st = b / 1024, sb = b % 1024, swz = sb ^ (((sb >> 9) & 1) << 5); R = (st >> 1) * 16 + swz / 64; C = (st & 1) * 32 + (swz % 64) / 2; }
typedef int v8i_t __attribute__((ext_vector_type(8))); typedef int v4i_t __attribute__((ext_vector_type(4)));
__device__ __forceinline__ v8i_t cat8(bf16x8 a, bf16x8 b) { const v4i_t x = __builtin_bit_cast(v4i_t, a), y = __builtin_bit_cast(v4i_t, b); return __builtin_shufflevector(x, y, 0, 1, 2, 3, 4, 5, 6, 7); }
struct Unit { int pm, pn, hf, roff; };
struct Gemm { const bf16_t* A; const bf16_t* Bt; int lda, ldb, K; const int* rowidx; };
struct StaticOrder {
    int nM, nN, nwg, G, c, full, tail2;
    __device__ __forceinline__ void init(int nM_, int nN_, int G_, int c_) { nM = nM_; nN = nN_; nwg = nM * nN; G = G_; c = c_; full = (nwg / G) * G; const int R = nwg - full; tail2 = (R > 0 && 2 * R <= G) ? 2 * R : 0; }
    __device__ __forceinline__ bool next(int i, Unit& u) const {
        if (tail2 && c < tail2 && (c & 1)) { const int rt = full / G; if (i > rt) return false; i = (i == 0) ? rt : i - 1; }
        const long L = (long)i * G + c; int wgid; u.hf = -1; u.roff = 0;
        if (tail2 && L >= full) { const int t = (int)(L - full); if (t >= tail2) return false; wgid = full + (t >> 1); u.hf = t & 1; }
        else { if (L >= nwg) return false; wgid = (int)L; }
        { const int q = nwg / NXCD, r = nwg % NXCD, xcd = wgid % NXCD, off = wgid / NXCD; wgid = (xcd < r ? xcd * (q + 1) : r * (q + 1) + (xcd - r) * q) + off; }
        const int nig = WGM * nN, gid = wgid / nig, fm = gid * WGM, gsz = (nM - fm) < WGM ? (nM - fm) : WGM;
        u.pm = fm + ((wgid % nig) % gsz); u.pn = (wgid % nig) / gsz; return true;
    }
};
struct GroupedOrder {
    StaticOrder so; int o1, o2, o3, o4, o5, o6, o7;
    __device__ __forceinline__ bool next(int i, Unit& u) const {
        if (!so.next(i, u)) return false;
        const int r0 = u.pm * BM; const int e = (r0 >= o1) + (r0 >= o2) + (r0 >= o3) + (r0 >= o4) + (r0 >= o5) + (r0 >= o6) + (r0 >= o7);
        int oe = 0; if (r0 >= o1) oe = o1; if (r0 >= o2) oe = o2; if (r0 >= o3) oe = o3; if (r0 >= o4) oe = o4; if (r0 >= o5) oe = o5; if (r0 >= o6) oe = o6; if (r0 >= o7) oe = o7;
        u.pn += e * so.nN; u.roff = e * T - oe; return true;
    }
};
template <class Epi, class Sched, bool ALIGN_EPI, bool GATHER, bool FP8 = false>
__device__ __forceinline__ void gemm_phase(int wv, PG8_LAS unsigned char* lds, const Gemm g, const Sched& S, const Epi& E) {
    const int tid = otid(wv), wid = __builtin_amdgcn_readfirstlane(tid >> 6), lane = tid & 63, wr = wid >> 2, wc = wid & 3, fr = lane & 15, fq = lane >> 4;
    const int K = g.K, nt = K / BK;
    int Rr[2]; unsigned cA2[2]; unsigned voffA[2][2], nvoffA[2][2], voffB[2];
#pragma unroll
    for (int i = 0; i < 2; ++i) { int R, C; stage_rc(tid * 16 + i * 8192, R, C); Rr[i] = R; cA2[i] = (unsigned)C * 2u;
        voffA[0][i] = (unsigned)(R * g.lda + C) * 2u; voffA[1][i] = (unsigned)((R + HALF) * g.lda + C) * 2u; voffB[i] = (unsigned)(R * g.ldb + C) * 2u;
        nvoffA[0][i] = voffA[0][i]; nvoffA[1][i] = voffA[1][i]; }
    const size_t kstep = (size_t)(BK * 2);
    const size_t hstepB = (size_t)HALF * g.ldb * 2, tstepB = 2 * hstepB, tstepA = (size_t)BM * g.lda * 2;
    const unsigned ldsw = (unsigned)wid * 1024u;
    const int aoff = lds_byte(wr * 64 + fr, fq * 8), boff = lds_byte(wc * 32 + fr, fq * 8);
#define PG8_SA(b, h) (((b) * 2 + (h)) * HTB)
#define PG8_SB(b, h) ((4 + (b) * 2 + (h)) * HTB)
#define PG8_STAGE(bufoff, gbase, voff) do { _Pragma("unroll") for (int _i = 0; _i < 2; ++_i) \
        __builtin_amdgcn_global_load_lds((const unsigned*)((const char*)(gbase) + (voff)[_i]), (PG8_LAS unsigned*)(lds + (bufoff) + ldsw + _i * 8192), 16, 0, 0); } while (0)
#define PG8_STAGE_SEL(bufoff, gbase, sel, vn, vc) do { _Pragma("unroll") for (int _i = 0; _i < 2; ++_i) \
        __builtin_amdgcn_global_load_lds((const unsigned*)((const char*)(gbase) + ((sel) ? (vn)[_i] : (vc)[_i])), (PG8_LAS unsigned*)(lds + (bufoff) + ldsw + _i * 8192), 16, 0, 0); } while (0)
#define PG8_LDA(dst, b, h) do { _Pragma("unroll") for (int m = 0; m < 4; ++m) { \
        if constexpr (FP8) dst##8[m] = cat8(*(const PG8_LAS bf16x8*)(lds + PG8_SA(b, h) + aoff + m * 2048), *(const PG8_LAS bf16x8*)(lds + PG8_SA(b, h) + aoff + m * 2048 + 1024)); \
        else { _Pragma("unroll") for (int k = 0; k < 2; ++k) dst[m][k] = *(const PG8_LAS bf16x8*)(lds + PG8_SA(b, h) + aoff + m * 2048 + k * 1024); } } } while (0)
#define PG8_LDB(dst, b, h) do { _Pragma("unroll") for (int n = 0; n < 2; ++n) { \
        if constexpr (FP8) dst##8[n] = cat8(*(const PG8_LAS bf16x8*)(lds + PG8_SB(b, h) + boff + n * 2048), *(const PG8_LAS bf16x8*)(lds + PG8_SB(b, h) + boff + n * 2048 + 1024)); \
        else { _Pragma("unroll") for (int k = 0; k < 2; ++k) dst[n][k] = *(const PG8_LAS bf16x8*)(lds + PG8_SB(b, h) + boff + n * 2048 + k * 1024); } } } while (0)
#define PG8_MMA(ai, bj, At, Bt) do { __builtin_amdgcn_s_setprio(1); _Pragma("unroll") for (int m = 0; m < 4; ++m) _Pragma("unroll") for (int n = 0; n < 2; ++n) { \
        if constexpr (FP8) asm volatile("v_mfma_scale_f32_16x16x128_f8f6f4 %0, %1, %2, %0, %3, %3 op_sel_hi:[0,0,0]" : "+v"(acc[ai][bj][m][n]) : "v"(Bt##8[n]), "v"(At##8[m]), "v"(one_scale));     \
        else { _Pragma("unroll") for (int k = 0; k < 2; ++k) acc[ai][bj][m][n] = __builtin_amdgcn_mfma_f32_16x16x32_bf16(Bt[n][k], At[m][k], acc[ai][bj][m][n], 0, 0, 0); } } __builtin_amdgcn_s_setprio(0); } while (0)
#define PG8_WAIT_V(n) asm volatile("s_waitcnt vmcnt(" #n ")" ::: "memory")
#define PG8_WAIT_L(n) asm volatile("s_waitcnt lgkmcnt(" #n ")" ::: "memory")
#define PG8_BAR __builtin_amdgcn_s_barrier()
#define PG8_SCHED __builtin_amdgcn_sched_barrier(0)
#define PG8_GATHER_OFF(dst, u_) do { _Pragma("unroll") for (int _h = 0; _h < 2; ++_h) _Pragma("unroll") for (int _i = 0; _i < 2; ++_i) \
        dst[_h][_i] = (unsigned)g.rowidx[(u_).roff + (u_).pm * BM + ((u_).hf < 0 ? _h : (u_).hf) * HALF + Rr[_i]] * (unsigned)(g.lda * 2) + cA2[_i]; } while (0)
    Unit cur, nxt; int ui = 0;
    if (!S.next(0, cur)) return;
    f32x4 acc[2][2][4][2];
#pragma unroll
    for (int a = 0; a < 2; ++a)
#pragma unroll
        for (int b = 0; b < 2; ++b)
#pragma unroll
            for (int m = 0; m < 4; ++m)
#pragma unroll
                for (int n = 0; n < 2; ++n) { acc[a][b][m][n] = (f32x4){0.f, 0.f, 0.f, 0.f}; if constexpr (FP8) asm volatile("" : "+v"(acc[a][b][m][n])); }
    const int one_scale = 0x7f7f7f7f;
    bf16x8 At[4][2], B0[2][2], B1[2][2]; v8i_t At8[4], B08[2], B18[2];
    if constexpr (GATHER) { PG8_GATHER_OFF(voffA, cur); }
    const size_t hstepA = (size_t)HALF * g.lda * 2;
    if (cur.hf >= 0) { voffA[1][0] = 0u; voffA[1][1] = 0u; }
    const char* cA = (const char*)g.A + (GATHER ? (size_t)0 : (size_t)cur.pm * tstepA + (cur.hf > 0 ? hstepA : (size_t)0)); const char* cB = (const char*)g.Bt + (size_t)cur.pn * tstepB;
    PG8_STAGE(PG8_SB(0, 0), cB, voffB); PG8_STAGE(PG8_SB(0, 1), cB + hstepB, voffB); PG8_STAGE(PG8_SA(0, 0), cA, voffA[0]); PG8_STAGE(PG8_SA(0, 1), cA, voffA[1]);
    if (wr == 1) PG8_BAR;
    PG8_WAIT_V(2); PG8_BAR;
    PG8_STAGE(PG8_SB(1, 0), cB + kstep, voffB); PG8_STAGE(PG8_SA(1, 0), cA + kstep, voffA[0]); PG8_STAGE(PG8_SB(1, 1), cB + hstepB + kstep, voffB);
    PG8_WAIT_V(6); PG8_BAR;
    for (;;) {
        const bool has_next = S.next(ui + 1, nxt);
        if constexpr (!GATHER) { const bool nh = has_next ? (nxt.hf >= 0) : (cur.hf >= 0); const unsigned hs = (unsigned)(HALF * g.lda * 2);
            nvoffA[1][0] = nh ? 0u : voffA[0][0] + hs; nvoffA[1][1] = nh ? 0u : voffA[0][1] + hs; }
        if constexpr (GATHER) { if (has_next) { PG8_GATHER_OFF(nvoffA, nxt); } else {
#pragma unroll
            for (int h = 0; h < 2; ++h)
#pragma unroll
                for (int i = 0; i < 2; ++i) nvoffA[h][i] = voffA[h][i]; } }
        const char* nA = GATHER ? (const char*)g.A : (has_next ? (const char*)g.A + (size_t)nxt.pm * tstepA + (nxt.hf > 0 ? hstepA : (size_t)0) : cA); const char* nB = has_next ? (const char*)g.Bt + (size_t)nxt.pn * tstepB : cB;
#pragma unroll 1
        for (int t = 0; t < nt; t += 2) {
            const bool last = (t == nt - 2);
            const char* a1 = cA + (size_t)(t + 1) * kstep;
            const char* a2 = last ? nA : cA + (size_t)(t + 2) * kstep; const char* b2 = last ? nB : cB + (size_t)(t + 2) * kstep;
            const char* a3 = a2 + kstep; const char* b3 = b2 + kstep;
            const bool sel = last;
            PG8_LDB(B0, 0, 0); PG8_LDB(B1, 0, 1); PG8_SCHED; PG8_LDA(At, 0, 0); PG8_STAGE(PG8_SA(1, 1), a1, voffA[1]);
            PG8_WAIT_V(8); PG8_WAIT_L(0); PG8_BAR; PG8_MMA(0, 0, At, B0); PG8_MMA(0, 1, At, B1); PG8_BAR; PG8_SCHED;
            PG8_LDA(At, 0, 1); PG8_STAGE(PG8_SB(0, 0), b2, voffB); PG8_STAGE(PG8_SB(0, 1), b2 + hstepB, voffB); PG8_STAGE_SEL(PG8_SA(0, 0), a2, sel, nvoffA[0], voffA[0]);
            PG8_WAIT_V(8); PG8_WAIT_L(0); PG8_BAR; if (cur.hf < 0) { PG8_MMA(1, 0, At, B0); PG8_MMA(1, 1, At, B1); } PG8_BAR; PG8_SCHED;
            PG8_LDB(B0, 1, 0); PG8_LDB(B1, 1, 1); PG8_SCHED; PG8_LDA(At, 1, 0); PG8_STAGE_SEL(PG8_SA(0, 1), a2, sel, nvoffA[1], voffA[1]);
            PG8_WAIT_V(8); PG8_WAIT_L(0); PG8_BAR; PG8_MMA(0, 0, At, B0); PG8_MMA(0, 1, At, B1); PG8_BAR; PG8_SCHED;
            PG8_LDA(At, 1, 1); PG8_STAGE(PG8_SB(1, 0), b3, voffB); PG8_STAGE(PG8_SB(1, 1), b3 + hstepB, voffB); PG8_STAGE_SEL(PG8_SA(1, 0), a3, sel, nvoffA[0], voffA[0]);
            PG8_WAIT_V(8); PG8_WAIT_L(0); PG8_BAR; if (cur.hf < 0) { PG8_MMA(1, 0, At, B0); PG8_MMA(1, 1, At, B1); } PG8_BAR; PG8_SCHED;
        }
        if constexpr (ALIGN_EPI) { if (wr == 0) PG8_BAR; }
        if constexpr (FP8) asm volatile("s_nop 15\n\ts_nop 7" ::: "memory");
        E(acc, cur, wr, wc, fr, fq);
        if (!has_next) break;
#pragma unroll
        for (int a = 0; a < 2; ++a)
#pragma unroll
            for (int b = 0; b < 2; ++b)
#pragma unroll
                for (int m = 0; m < 4; ++m)
#pragma unroll
                    for (int n = 0; n < 2; ++n) { acc[a][b][m][n] = (f32x4){0.f, 0.f, 0.f, 0.f}; if constexpr (FP8) asm volatile("" : "+v"(acc[a][b][m][n])); }
        cur = nxt; cA = nA; cB = nB; ++ui;
        if constexpr (!GATHER) { voffA[1][0] = nvoffA[1][0]; voffA[1][1] = nvoffA[1][1]; }
        if constexpr (GATHER) {
#pragma unroll
            for (int h = 0; h < 2; ++h)
#pragma unroll
                for (int i = 0; i < 2; ++i) voffA[h][i] = nvoffA[h][i]; }
        if constexpr (ALIGN_EPI) { if (wr == 1) PG8_BAR; }
    }
    PG8_WAIT_V(0);
    if constexpr (!ALIGN_EPI) { if (wr == 0) PG8_BAR; }
    PG8_BAR;
#undef PG8_SA
#undef PG8_SB
#undef PG8_STAGE
#undef PG8_STAGE_SEL
#undef PG8_LDA
#undef PG8_LDB
#undef PG8_MMA
#undef PG8_WAIT_V
#undef PG8_WAIT_L
#undef PG8_BAR
#undef PG8_SCHED
#undef PG8_GATHER_OFF
}
template <class F> struct EpiW {
    F f; int nnmod;
    __device__ __forceinline__ void operator()(f32x4 (&acc)[2][2][4][2], const Unit& u, int wr, int wc, int fr, int fq) const {
        const int pn = nnmod ? (u.pn % nnmod) : u.pn; const int row0 = u.pm * BM + wr * 64 + fr, col0 = pn * BM + wc * 32 + 4 * fq;
        float rsv[2][4]; int auxv[2][4]; typename F::Raw rw[2][4];
#pragma unroll
        for (int ai = 0; ai < 2; ++ai) { if (ai == 1 && u.hf >= 0) break;
#pragma unroll
            for (int m = 0; m < 4; ++m) { const int row = row0 + (u.hf < 0 ? ai : u.hf) * HALF + m * 16; rw[ai][m] = f.raw(row + u.roff, fq); auxv[ai][m] = f.aux(row + u.roff); } }
#pragma unroll
        for (int ai = 0; ai < 2; ++ai) { if (ai == 1 && u.hf >= 0) break;
#pragma unroll
            for (int m = 0; m < 4; ++m) rsv[ai][m] = f.fin(rw[ai][m]); }
        if constexpr (F::HAS_PRE) {
#pragma unroll
            for (int ai = 0; ai < 2; ++ai) { if (ai == 1 && u.hf >= 0) break;
#pragma unroll
                for (int m = 0; m < 4; ++m) { int row = row0 + (u.hf < 0 ? ai : u.hf) * HALF + m * 16; if ((m & 1) == 0) asm volatile("" : "+v"(row) :: "memory");
#pragma unroll
                    for (int bj = 0; bj < 2; ++bj) f.pre(row, col0 + bj * HALF, acc[ai][bj][m][0], acc[ai][bj][m][1]); } }
        }
#pragma unroll
        for (int ai = 0; ai < 2; ++ai) { if (ai == 1 && u.hf >= 0) break;
#pragma unroll
            for (int m = 0; m < 4; ++m) {
                int row = row0 + (u.hf < 0 ? ai : u.hf) * HALF + m * 16; asm volatile("" : "+v"(row) :: "memory");
#pragma unroll
                for (int bj = 0; bj < 2; ++bj) { const int col = col0 + bj * HALF;
                    float s = f(row, col, acc[ai][bj][m][0], acc[ai][bj][m][1], rsv[ai][m], auxv[ai][m]);
                    if constexpr (F::HAS_STAT) { s = fq_sum(s); if (fq == 0) f.stat(row, col, s); } }
            } }
    }
};
}


struct Raw32 { f32x4 a, b; };
__device__ __forceinline__ Raw32 raw32(const float* ss, int row, int fq) { Raw32 r; r.a = *(const f32x4*)(ss + (size_t)row * 32 + 8 * fq); r.b = *(const f32x4*)(ss + (size_t)row * 32 + 8 * fq + 4); return r; }
__device__ __forceinline__ float fin32(const Raw32& r) { return __builtin_amdgcn_rsqf(fq_sum(((r.a[0] + r.a[1]) + (r.a[2] + r.a[3])) + ((r.b[0] + r.b[1]) + (r.b[2] + r.b[3]))) * (1.0f / DM) + EPS); }
__device__ __forceinline__ float ssq8(f32x4 v0, f32x4 v1) { return ((v0[0] * v0[0] + v0[1] * v0[1]) + (v0[2] * v0[2] + v0[3] * v0[3])) + ((v1[0] * v1[0] + v1[1] * v1[1]) + (v1[2] * v1[2] + v1[3] * v1[3])); }
struct EpiIn {
    static constexpr bool HAS_STAT = true, HAS_PRE = false;
    const float* ssx; bf16_t *XL, *GY, *CQKV, *KR; float *SSQ, *SSKV; const float* tab; bf16_t* CQF;
    __device__ __forceinline__ int aux(int) const { return 0; }
    typedef Raw32 Raw;
    __device__ __forceinline__ Raw raw(int row, int fq) const { return raw32(ssx, row, fq); }
    __device__ __forceinline__ float fin(const Raw& r) const { return fin32(r); }
    __device__ __forceinline__ float operator()(int row, int col, f32x4 v0, f32x4 v1, float rs, int) const {
        if (col >= INC) return 0.f;
        v0 *= rs; v1 *= rs;
        if (col < 512) { store8bf_x(XL + (size_t)row * 512 + col, col, v0, v1); return 0.f; }
        if (col < 1024) { const int c = col - 512; f32x4 g0, g1;
#pragma unroll
            for (int e = 0; e < 4; ++e) { g0[e] = gelu_tanh(v0[e]); g1[e] = gelu_tanh(v1[e]); }
            store8bf_x(GY + (size_t)row * 512 + c, c, g0, g1); return 0.f; }
        if (col < 1408) { const int c = col - 1024;
            const auto rx = __builtin_amdgcn_permlane16_swap(pk2(v0[0], v0[1]), pk2(v1[0], v1[1]), false, false), ry = __builtin_amdgcn_permlane16_swap(pk2(v0[2], v0[3]), pk2(v1[2], v1[3]), false, false);
            const u32x4 w8 = {rx[0], ry[0], rx[1], ry[1]}; const int c8 = (c & 4) ? c + 12 : c;
            if (c8 >= QLORA) *(u32x4*)(CQKV + (size_t)row * 384 + c8) = w8;
            else *(u32x4*)(CQF + ((size_t)(((row >> 5) * 16 + (c8 >> 4)) * 64 + ((c8 >> 3) & 1) * 32 + (row & 31))) * 8) = w8;
            return ssq8(v0, v1); }
        { const int i0 = col - 1408; f32x4 o1, o2;
#pragma unroll
          for (int e = 0; e < 4; ++e) { const float c = tab[(size_t)row * 32 + 2 * (i0 + e)], s = tab[(size_t)row * 32 + 2 * (i0 + e) + 1]; o1[e] = v0[e] * c - v1[e] * s; o2[e] = v1[e] * c + v0[e] * s; }
          store4bf(KR + (size_t)row * 32 + i0, o1); store4bf(KR + (size_t)row * 32 + 16 + i0, o2); return 0.f; }
    }
    __device__ __forceinline__ void stat(int row, int col, float s) const {
        if (col >= 1024 && col < 1280) SSQ[(size_t)row * 8 + ((col - 1024) >> 5)] = s;
        else if (col >= 1280 && col < 1408) SSKV[(size_t)row * 4 + ((col - 1280) >> 5)] = s;
    }
};
struct EpiQ {
    static constexpr bool HAS_STAT = false, HAS_PRE = false;
    const float* ssq; bf16_t* QF; const float* tab;
    __device__ __forceinline__ int aux(int) const { return 0; }
    typedef f32x2_t Raw;
    __device__ __forceinline__ Raw raw(int row, int fq) const { return *(const f32x2_t*)(ssq + (size_t)row * 8 + 2 * fq); }
    __device__ __forceinline__ float fin(const Raw& r) const { return __builtin_amdgcn_rsqf(fq_sum(r[0] + r[1]) * (1.0f / QLORA) + EPS) * QSCALE; }
    __device__ __forceinline__ float operator()(int row, int col, f32x4 v0, f32x4 v1, float rs, int) const {
        v0 *= rs; v1 *= rs;
        const int j = col % DQK;
        if (j < 64) { store8bf_x(QF + (size_t)row * QW + col, col, v0, v1); }
        else { const int i0 = j - 64; f32x4 o1, o2;
#pragma unroll
            for (int e = 0; e < 4; ++e) { const float c = tab[(size_t)row * 32 + 2 * (i0 + e)], s = tab[(size_t)row * 32 + 2 * (i0 + e) + 1]; o1[e] = v0[e] * c - v1[e] * s; o2[e] = v1[e] * c + v0[e] * s; }
            store4bf(QF + (size_t)row * QW + col, o1); store4bf(QF + (size_t)row * QW + col + 16, o2); }
        return 0.f;
    }
    __device__ __forceinline__ void stat(int, int, float) const {}
};
struct EpiKV {
    static constexpr bool HAS_STAT = false, HAS_PRE = false;
    const float* sskv; bf16_t *KN, *VT;
    __device__ __forceinline__ int aux(int) const { return 0; }
    typedef float Raw;
    __device__ __forceinline__ Raw raw(int row, int fq) const { return sskv[(size_t)row * 4 + fq]; }
    __device__ __forceinline__ float fin(const Raw& r) const { return __builtin_amdgcn_rsqf(fq_sum(r) * (1.0f / KVLORA) + EPS); }
    __device__ __forceinline__ float operator()(int row, int col, f32x4 v0, f32x4 v1, float rs, int) const {
        v0 *= rs; v1 *= rs;
        const int h = col >> 7, j = col & 127;
        if (j < 64) { bf16_t* kn = KN + (size_t)row * 512 + h * 64 + j; store8bf_x(kn, j, v0, v1); }
        else { const int d = j - 64, b = row / SEQ, s = row % SEQ; bf16_t* vt = VT + ((size_t)(b * NH + h) * VH + d) * SEQ + s;
#pragma unroll
            for (int e = 0; e < 4; ++e) { vt[(size_t)e * SEQ] = (bf16_t)f2bf(v0[e]); vt[(size_t)(e + 16) * SEQ] = (bf16_t)f2bf(v1[e]); } }
        return 0.f;
    }
    __device__ __forceinline__ void stat(int, int, float) const {}
};
struct EpiRes {
    static constexpr bool HAS_STAT = true, HAS_PRE = true;
    bf16_t* XR; unsigned char* X8; float* SSX; float accscale;
    typedef int Raw;
    __device__ __forceinline__ Raw raw(int, int) const { return 0; }
    __device__ __forceinline__ float fin(const Raw&) const { return 1.f; }
    __device__ __forceinline__ int aux(int) const { return 0; }
    __device__ __forceinline__ void pre(int row, int col, f32x4& v0, f32x4& v1) const {
        const size_t o = (size_t)row * DM + col;
        { const u32x2 a = *(const u32x2*)(XR + o), b = *(const u32x2*)(XR + o + 16);
            v0 = v0 * accscale + (f32x4){bf2f(a.x & 0xffff), bf2f(a.x >> 16), bf2f(a.y & 0xffff), bf2f(a.y >> 16)}; v1 = v1 * accscale + (f32x4){bf2f(b.x & 0xffff), bf2f(b.x >> 16), bf2f(b.y & 0xffff), bf2f(b.y >> 16)}; }
    }
    __device__ __forceinline__ float operator()(int row, int col, f32x4 a, f32x4 b, float, int) const {
        const size_t o = (size_t)row * DM + col;
        store8bf_x(XR + o, col, a, b);
        if (X8) { unsigned char* x8 = X8 + o; *(unsigned*)x8 = pk4_fp8(a[0] * F8_XS, a[1] * F8_XS, a[2] * F8_XS, a[3] * F8_XS); *(unsigned*)(x8 + 16) = pk4_fp8(b[0] * F8_XS, b[1] * F8_XS, b[2] * F8_XS, b[3] * F8_XS); }
        return ssq8(a, b);
    }
    __device__ __forceinline__ void stat(int row, int col, float s) const { SSX[(size_t)row * 32 + (col >> 5)] = s; }
};
template <bool F8> struct GURaw { typedef Raw32 T; }; template <> struct GURaw<true> { typedef float T; };
template <bool F8> struct EpiGU {
    static constexpr bool HAS_STAT = false, HAS_PRE = false;
    const float* ssx; const int* rowtok; bf16_t* ACT; int ldact;
    __device__ __forceinline__ int aux(int) const { return 0; }
    typedef typename GURaw<F8>::T Raw;
    __device__ __forceinline__ Raw raw(int row, int fq) const { if constexpr (F8) return ssx[row]; else return raw32(ssx, row, fq); }
    __device__ __forceinline__ float fin(const Raw& r) const { if constexpr (F8) return r; else return fin32(r); }
    __device__ __forceinline__ float operator()(int row, int col, f32x4 v0, f32x4 v1, float rs, int) const {
        f32x4 o;
        const float sc = F8 ? rs * (1.0f / (F8_XS * F8_WS)) : rs;
#pragma unroll
        for (int e = 0; e < 4; ++e) { const float g = v0[e] * sc, u = v1[e] * sc; o[e] = g * sigmoidf_(g) * u; }
        if (F8) *(unsigned*)((unsigned char*)ACT + (size_t)row * ldact + (col >> 5) * 16 + (col & 31)) = pk4_fp8(o[0] * F8_AS, o[1] * F8_AS, o[2] * F8_AS, o[3] * F8_AS);
        else store4bf_x(ACT + (size_t)row * ldact + (col >> 5) * 16 + (col & 31), col, o);
        return 0.f;
    }
    __device__ __forceinline__ void stat(int, int, float) const {}
};
struct EpiED {
    static constexpr bool HAS_STAT = false, HAS_PRE = false;
    const float* roww; const int* rowslot; bf16_t* Y;
    typedef float Raw;
    __device__ __forceinline__ Raw raw(int row, int) const { return roww[row]; }
    __device__ __forceinline__ float fin(const Raw& r) const { return r; }
    __device__ __forceinline__ int aux(int row) const { return rowslot[row]; }
    __device__ __forceinline__ float operator()(int, int col, f32x4 v0, f32x4 v1, float w, int slot) const {
        if (slot < 0) return 0.f;
        const float ws_ = w * (F8_YS / (F8_AS * F8_WS)); unsigned char* y8 = (unsigned char*)Y + (size_t)slot * DM + col;
        *(unsigned*)y8 = pk4_fp8(v0[0] * ws_, v0[1] * ws_, v0[2] * ws_, v0[3] * ws_); *(unsigned*)(y8 + 16) = pk4_fp8(v1[0] * ws_, v1[1] * ws_, v1[2] * ws_, v1[3] * ws_); return 0.f;
    }
    __device__ __forceinline__ void stat(int, int, float) const {}
};

template <class F, bool ALIGN>
__device__ __forceinline__ void gemm_static(int wv, const bf16_t* A, int lda, const bf16_t* Bt, int ldb, int M, int N, int K, const F& f, int bid, int nb, unsigned char* smem) {
    pg8::Gemm g{A, Bt, lda, ldb, K, nullptr}; pg8::StaticOrder S; S.init(M / 256, N / 256, nb, bid); pg8::EpiW<F> E{f, 0};
    pg8::gemm_phase<pg8::EpiW<F>, pg8::StaticOrder, ALIGN, false>(wv, (PG8_LAS unsigned char*)smem, g, S, E);
}

__device__ __forceinline__ void expert_offsets(const int* cnt, int (&off)[NE + 1]) {
    int o = 0;
#pragma unroll
    for (int e = 0; e < NE; ++e) { off[e] = o; o += (cnt[e] + 255) & ~255; }
    off[NE] = o;
}

constexpr int XCS_LD = 520;
constexpr int LRU_XL = 0, LRU_XCS = 35 * 1024, LRU_GR = LRU_XCS + 16 * XCS_LD * 2, LRU_GI = LRU_GR + 16 * 512 * 4, LRU_GY = LRU_GI + 16 * 512 * 4, LRU_LDS = LRU_GY + 32 * 1024;
template <bool FIN>
__device__ __forceinline__ void lru_phase(PP p, int wv, int l, int bid, int nb, unsigned char* smem) {
    const int c = otid(wv), lane = c & 63, fr = lane & 15, fq = lane >> 4;
    unsigned char* ws = p->ws;
    const bf16_t* XL = (const bf16_t*)(ws + WS_XL); const bf16_t* GY = (const bf16_t*)(ws + WS_GY); bf16_t* MIX = (bf16_t*)(ws + WS_MIX); float* SUM = (float*)(ws + WS_SUM); unsigned* LAU = (unsigned*)(ws + WS_LAU);
    bf16_t* xls = (bf16_t*)(smem + LRU_XL); bf16_t* xcs = (bf16_t*)(smem + LRU_XCS); float* gr = (float*)(smem + LRU_GR); float* gi = (float*)(smem + LRU_GI); bf16_t* gys = (bf16_t*)(smem + LRU_GY);
    bf16x8 wf[2][4][2];
    { const bf16_t* lw = (const bf16_t*)(ws + WS_LW) + (size_t)((l * 8 + wv) * 2) * 4096;
#pragma unroll
      for (int w = 0; w < 2; ++w)
#pragma unroll
          for (int dt = 0; dt < 4; ++dt)
#pragma unroll
              for (int ks = 0; ks < 2; ++ks) wf[w][dt][ks] = *(const bf16x8*)(lw + (size_t)w * 4096 + (dt * 16 + fr) * 64 + ks * 32 + fq * 8); }
    const float ba = p->lru_ba[l * LRU_W + c], bx = p->lru_bx[l * LRU_W + c];
    const float lam = p->lru_lambda[l * LRU_W + c]; const float sp8 = -8.0f * 1.4426950408889634f * log1pf(expf(-lam));
    const float cw0 = p->conv_w[(l * 4 + 0) * LRU_W + c], cw1 = p->conv_w[(l * 4 + 1) * LRU_W + c], cw2 = p->conv_w[(l * 4 + 2) * LRU_W + c], cw3 = p->conv_w[(l * 4 + 3) * LRU_W + c], cb = p->conv_b[l * LRU_W + c];
    for (int ch = bid; ch < T / 64; ch += nb) {
        const int t0 = ch * 64, s0 = t0 % SEQ;
        u32x4 pre[5], pg[4];
#define LRU_LOAD(hf) do { _Pragma("unroll") for (int j = 0; j < 5; ++j) { const int pc = c + 512 * j; const int row = pc >> 6, tk = t0 + 32 * (hf) - 3 + row; \
            pre[j] = (u32x4){0u, 0u, 0u, 0u}; if (pc < 2240 && !((hf) == 0 && s0 == 0 && row < 3)) pre[j] = *(const u32x4*)(XL + (size_t)tk * 512 + (pc & 63) * 8); } \
            if (FIN) { _Pragma("unroll") for (int j = 0; j < 4; ++j) { const int pc = c + 512 * j; pg[j] = *(const u32x4*)(GY + (size_t)(t0 + 32 * (hf) + (pc >> 6)) * 512 + (pc & 63) * 8); } } } while (0)
#define LRU_STORE() do { _Pragma("unroll") for (int j = 0; j < 5; ++j) { const int pc = c + 512 * j; if (pc < 2240) *(u32x4*)(xls + pc * 8) = pre[j]; } \
            if (FIN) { _Pragma("unroll") for (int j = 0; j < 4; ++j) *(u32x4*)(gys + (c + 512 * j) * 8) = pg[j]; } } while (0)
        LRU_LOAD(0);
        float h = 0.f, Aacc = 1.f;
        if (FIN) { const int cfirst = (t0 / SEQ) * (SEQ / 64);
            for (int cc = cfirst; cc < ch; cc += 8) { float a_[8], h_[8];
#pragma unroll
                for (int q = 0; q < 8; ++q) { const bool ok = cc + q < ch; a_[q] = ok ? SUM[(size_t)(cc + q) * 1024 + c] : 1.f; h_[q] = ok ? SUM[(size_t)(cc + q) * 1024 + 512 + c] : 0.f; }
#pragma unroll
                for (int q = 0; q < 8; ++q) h = a_[q] * h + h_[q]; } }
        LRU_STORE();
        __syncthreads();
#pragma unroll 1
        for (int hf = 0; hf < 2; ++hf) {
            if (hf == 0) LRU_LOAD(1);
#pragma unroll 1
            for (int sub = 0; sub < 2; ++sub) {
                const int tb = t0 + 32 * hf + 16 * sub;
                const bf16_t* xr = xls + (16 * sub) * 512 + c;
                { float x0 = bf2f(xr[0]), x1 = bf2f(xr[512]), x2 = bf2f(xr[1024]);
#pragma unroll 4
                  for (int tt = 0; tt < 16; ++tt) { const float x3 = bf2f(xr[(tt + 3) * 512]); const float xcv = cb + cw0 * x0 + cw1 * x1 + cw2 * x2 + cw3 * x3; x0 = x1; x1 = x2; x2 = x3; xcs[tt * XCS_LD + c] = (bf16_t)f2bf(xcv); } }
                __syncthreads();
                { f32x4 ar[4], ai[4];
#pragma unroll
                  for (int dt = 0; dt < 4; ++dt) { ar[dt] = (f32x4){0.f, 0.f, 0.f, 0.f}; ai[dt] = (f32x4){0.f, 0.f, 0.f, 0.f}; }
#pragma unroll
                  for (int ks = 0; ks < 2; ++ks) { const bf16x8 af = *(const bf16x8*)(xcs + fr * XCS_LD + wv * 64 + ks * 32 + fq * 8);
#pragma unroll
                      for (int dt = 0; dt < 4; ++dt) { ar[dt] = __builtin_amdgcn_mfma_f32_16x16x32_bf16(af, wf[0][dt][ks], ar[dt], 0, 0, 0); ai[dt] = __builtin_amdgcn_mfma_f32_16x16x32_bf16(af, wf[1][dt][ks], ai[dt], 0, 0, 0); } }
#pragma unroll
                  for (int dt = 0; dt < 4; ++dt)
#pragma unroll
                      for (int r = 0; r < 4; ++r) { gr[(4 * fq + r) * 512 + wv * 64 + dt * 16 + fr] = ar[dt][r]; gi[(4 * fq + r) * 512 + wv * 64 + dt * 16 + fr] = ai[dt][r]; } }
                __syncthreads();
                { float x0 = bf2f(xr[0]), x1 = bf2f(xr[512]), x2 = bf2f(xr[1024]);
#pragma unroll 4
                  for (int tt = 0; tt < 16; ++tt) {
                    const float x3 = bf2f(xr[(tt + 3) * 512]); const float xcv = cb + cw0 * x0 + cw1 * x1 + cw2 * x2 + cw3 * x3; x0 = x1; x1 = x2; x2 = x3;
                    const float r = sigmoidf_(gr[tt * 512 + c] + ba), ig = sigmoidf_(gi[tt * 512 + c] + bx);
                    const float a = __builtin_amdgcn_exp2f(sp8 * r); float mult = __builtin_amdgcn_sqrtf(1.0f - a * a);
                    const int t = tb + tt; if ((t % SEQ) == 0) mult = 1.0f;
                    const float u = mult * (ig * xcv);
                    h = a * h + u; Aacc *= a;
                    if (!FIN) LAU[(size_t)t * 512 + c] = pk2(sp8 * r, u);
                    if (FIN) MIX[(size_t)t * DM + c] = (bf16_t)f2bf(h * bf2f(gys[(16 * sub + tt) * 512 + c]));
                  } }
                __syncthreads();
            }
            if (hf == 0) { LRU_STORE(); __syncthreads(); }
        }
        if (!FIN) { SUM[(size_t)ch * 1024 + c] = Aacc; SUM[(size_t)ch * 1024 + 512 + c] = h; }
#undef LRU_LOAD
#undef LRU_STORE
    }
}

constexpr int LRU_LDS_LAU = 10240;
__device__ __forceinline__ void lru_sum_phase(PP p, int wv, int l, int bid, int nb, unsigned char* smem) {
    const int tid = otid(wv), lane = tid & 63, fr = lane & 15, fq = lane >> 4;
    unsigned char* ws = p->ws;
    const bf16_t* XL = (const bf16_t*)(ws + WS_XL); float* SUM = (float*)(ws + WS_SUM); unsigned* LAU = (unsigned*)(ws + WS_LAU);
    const int cbase = wv * 64 + 8 * fq;
    u32x4 xr[5][2];
    { const int t0 = bid * 64; const bool seqstart = (t0 % SEQ) == 0;
      const unsigned char* xb_ = (const unsigned char*)(XL + ((ptrdiff_t)t0 - 16) * LRU_W) + (unsigned)((fr * LRU_W + cbase) * 2);
#pragma unroll
      for (int s5 = 0; s5 < 5; ++s5)
#pragma unroll
          for (int ks = 0; ks < 2; ++ks) { xr[s5][ks] = (u32x4){0u, 0u, 0u, 0u}; if (bid < T / 64 && !(seqstart && s5 == 0)) xr[s5][ks] = *(const u32x4*)(xb_ + ((size_t)s5 * 16 * LRU_W * 2 + ks * 64)); } }
    float* cwl = (float*)smem;
    for (int i = tid; i < 5 * LRU_W; i += NTHR) { const int k = i >> 9, c = i & 511; cwl[i] = k < 4 ? p->conv_w[(l * 4 + k) * LRU_W + c] : p->conv_b[l * LRU_W + c]; }
    bf16x8 wga[2][4], wgx[2][4];
    { const bf16_t* lw = (const bf16_t*)(ws + WS_LW) + (size_t)((l * 8 + wv) * 2) * 4096 + fr * 64 + fq * 8;
#pragma unroll
      for (int ks = 0; ks < 2; ++ks)
#pragma unroll
          for (int dt = 0; dt < 4; ++dt) { wga[ks][dt] = *(const bf16x8*)(lw + dt * 1024 + ks * 32); wgx[ks][dt] = *(const bf16x8*)(lw + 4096 + dt * 1024 + ks * 32); } }
    float ba[4], bx[4], sp8[4];
#pragma unroll
    for (int dt = 0; dt < 4; ++dt) { const int c = l * LRU_W + wv * 64 + dt * 16 + fr; ba[dt] = -1.4426950408889634f * p->lru_ba[c]; bx[dt] = -1.4426950408889634f * p->lru_bx[c]; sp8[dt] = ((const float*)(ws + WS_SP8))[c]; }
    bf16x8 idf[2];
#pragma unroll
    for (int q = 0; q < 2; ++q) { const int j = 16 * q + fr - 8 * fq; u32x4 w = {0u, 0u, 0u, 0u};
#pragma unroll
        for (int d = 0; d < 4; ++d) { if (j == 2 * d) w[d] = 0x3F80u; if (j == 2 * d + 1) w[d] = 0x3F800000u; }
        idf[q] = __builtin_bit_cast(bf16x8, w); }
    __syncthreads();
    { const int ch = bid; if (ch >= T / 64) return;
        const int t0 = ch * 64; const bool seqstart = (t0 % SEQ) == 0;
        float Ar[4] = {1.f, 1.f, 1.f, 1.f}, Hr[4] = {0.f, 0.f, 0.f, 0.f};

#pragma unroll
        for (int sub = 0; sub < 4; ++sub) {
            unsigned oz = 0u; asm volatile("" : "+v"(oz)); const LAS float* cwo = (const LAS float*)((const LAS unsigned char*)smem + oz);
            bf16x8 af[2];
#pragma unroll
            for (int ks = 0; ks < 2; ++ks) { u32x4 pk; u32x4 tp[4]; tp[3] = xr[sub + 1][ks];
#pragma unroll
                for (int d = 0; d < 4; ++d) { const int cur = (int)xr[sub + 1][ks][d], prv = (int)xr[sub][ks][d];
                    tp[2][d] = (unsigned)__builtin_amdgcn_mov_dpp(fr < 15 ? cur : prv, 0x121, 0xf, 0xf, false);
                    tp[1][d] = (unsigned)__builtin_amdgcn_mov_dpp(fr < 14 ? cur : prv, 0x122, 0xf, 0xf, false);
                    tp[0][d] = (unsigned)__builtin_amdgcn_mov_dpp(fr < 13 ? cur : prv, 0x123, 0xf, 0xf, false); }
#pragma unroll
                for (int hj = 0; hj < 2; ++hj) { const LAS float* wp = cwo + cbase + 32 * ks + 4 * hj; f32x4 acc = *(const LAS f32x4*)(wp + 4 * LRU_W);
#pragma unroll
                    for (int tap = 0; tap < 4; ++tap) { const unsigned d0 = tp[tap][2 * hj], d1 = tp[tap][2 * hj + 1];
                        const f32x4 xv = {__uint_as_float(d0 << 16), __uint_as_float(d0 & 0xffff0000u), __uint_as_float(d1 << 16), __uint_as_float(d1 & 0xffff0000u)};
                        acc += *(const LAS f32x4*)(wp + tap * LRU_W) * xv; }
                    pk[2 * hj] = pk2(acc[0], acc[1]); pk[2 * hj + 1] = pk2(acc[2], acc[3]); }
                af[ks] = __builtin_bit_cast(bf16x8, pk); }
            f32x4 ar[4], ai[4], xd[4];
#pragma unroll
            for (int dt = 0; dt < 4; ++dt) { ar[dt] = (f32x4){ba[dt], ba[dt], ba[dt], ba[dt]}; ai[dt] = (f32x4){bx[dt], bx[dt], bx[dt], bx[dt]}; }
#pragma unroll
            for (int ks = 0; ks < 2; ++ks)
#pragma unroll
                for (int dt = 0; dt < 4; ++dt) { ar[dt] = __builtin_amdgcn_mfma_f32_16x16x32_bf16(af[ks], wga[ks][dt], ar[dt], 0, 0, 0); ai[dt] = __builtin_amdgcn_mfma_f32_16x16x32_bf16(af[ks], wgx[ks][dt], ai[dt], 0, 0, 0); }
#pragma unroll
            for (int dt = 0; dt < 4; ++dt) xd[dt] = __builtin_amdgcn_mfma_f32_16x16x32_bf16(af[dt >> 1], idf[dt & 1], (f32x4){0.f, 0.f, 0.f, 0.f}, 0, 0, 0);
            LAS unsigned char* lp = (LAS unsigned char*)smem + LRU_LDS_LAU + (sub * 8 + wv) * 4096 + fq * 1024;
#pragma unroll
            for (int dt = 0; dt < 4; ++dt)
#pragma unroll
                for (int r = 0; r < 4; ++r) { ar[dt][r] = __builtin_amdgcn_exp2f(ar[dt][r]); ai[dt][r] = __builtin_amdgcn_exp2f(ai[dt][r]); }
            __builtin_amdgcn_sched_barrier(0);
#pragma unroll
            for (int dt = 0; dt < 4; ++dt)
#pragma unroll
                for (int r = 0; r < 4; ++r) { ar[dt][r] = __builtin_amdgcn_rcpf(1.f + ar[dt][r]); ai[dt][r] = __builtin_amdgcn_rcpf(1.f + ai[dt][r]); }
            __builtin_amdgcn_sched_barrier(0);
            f32x4 av[4];
#pragma unroll
            for (int dt = 0; dt < 4; ++dt)
#pragma unroll
                for (int r = 0; r < 4; ++r) { ar[dt][r] = sp8[dt] * ar[dt][r]; av[dt][r] = __builtin_amdgcn_exp2f(ar[dt][r]); ai[dt][r] *= xd[dt][r]; }
            __builtin_amdgcn_sched_barrier(0);
#pragma unroll
            for (int dt = 0; dt < 4; ++dt)
#pragma unroll
                for (int r = 0; r < 4; ++r) { float mult = __builtin_amdgcn_sqrtf(1.0f - av[dt][r] * av[dt][r]);
                    if (r == 0) { if (seqstart && sub == 0 && fq == 0) mult = 1.0f; }
                    ai[dt][r] *= mult; }
            __builtin_amdgcn_sched_barrier(0);
#pragma unroll
            for (int dt = 0; dt < 4; ++dt) { float Al = 1.f, Hl = 0.f; u32x4 lw4;
#pragma unroll
                for (int r = 0; r < 4; ++r) { const float a = av[dt][r], u = ai[dt][r];
                    Hl = a * Hl + u; Al *= a;
                    lw4[r] = pk2(ar[dt][r], u);
                }
                *(LAS u32x4*)(lp + (((16 * dt + fr) ^ dt) << 4)) = lw4;
                { const auto sa = __builtin_amdgcn_permlane16_swap(__float_as_uint(Al), __float_as_uint(Al), false, false), sh = __builtin_amdgcn_permlane16_swap(__float_as_uint(Hl), __float_as_uint(Hl), false, false);
                  Hl = __uint_as_float(sh[0]) * __uint_as_float(sa[1]) + __uint_as_float(sh[1]); Al = __uint_as_float(sa[0]) * __uint_as_float(sa[1]); }
                { const auto sa = __builtin_amdgcn_permlane32_swap(__float_as_uint(Al), __float_as_uint(Al), false, false), sh = __builtin_amdgcn_permlane32_swap(__float_as_uint(Hl), __float_as_uint(Hl), false, false);
                  Hl = __uint_as_float(sh[0]) * __uint_as_float(sa[1]) + __uint_as_float(sh[1]); Al = __uint_as_float(sa[0]) * __uint_as_float(sa[1]); }
                Hr[dt] = Al * Hr[dt] + Hl; Ar[dt] *= Al; }
        }
        if (fq == 0) {
#pragma unroll
            for (int dt = 0; dt < 4; ++dt) { SUM[(size_t)ch * 1024 + wv * 64 + dt * 16 + fr] = Ar[dt]; SUM[(size_t)ch * 1024 + 512 + wv * 64 + dt * 16 + fr] = Hr[dt]; } }
    }
}

__device__ __forceinline__ void lru_scan_phase(PP p, int wv, int bid, int nb, unsigned char* smem) {
    const int tid = otid(wv), g = tid & 127, q = tid >> 7, qu = __builtin_amdgcn_readfirstlane(q); unsigned char* ws = p->ws;
    const bf16_t* GY = (const bf16_t*)(ws + WS_GY); bf16_t* MIX = (bf16_t*)(ws + WS_MIX); const float* SUM = (const float*)(ws + WS_SUM);
    const int c0 = 4 * g;
    LAS f32x2_t* qs = (LAS f32x2_t*)smem;
    const int ch = bid;
    if (ch < T / 64) {
        const int t0 = ch * 64, tq = t0 + 16 * qu;
        u32x4 lu[4][4]; u32x2 gy[16];
        f32x4 As = {1.f, 1.f, 1.f, 1.f}, Hs = {0.f, 0.f, 0.f, 0.f};
        const int cfirst = (t0 / SEQ) * (SEQ / 64), cseg = cfirst + 16 * qu;
        f32x4 a_[8], h_[8];
        if (cseg < ch) {
#pragma unroll
            for (int k = 0; k < 8; ++k) { a_[k] = *(const f32x4*)((const unsigned char*)(SUM + (size_t)(cseg + k) * 1024) + (unsigned)(c0 * 4)); h_[k] = *(const f32x4*)((const unsigned char*)(SUM + (size_t)(cseg + k) * 1024 + 512) + (unsigned)(c0 * 4)); } }
        { const LAS unsigned char* lb = (const LAS unsigned char*)smem + LRU_LDS_LAU + (q * 8 + (c0 >> 6)) * 4096; const int chl = c0 & 63, dtx = chl >> 4;
#pragma unroll
          for (int j = 0; j < 4; ++j)
#pragma unroll
              for (int fq = 0; fq < 4; ++fq) lu[j][fq] = *(const LAS u32x4*)(lb + fq * 1024 + (((chl + j) ^ dtx) << 4)); }
        if (cseg < ch) {
#pragma unroll
            for (int k = 0; k < 8; ++k) { if (cseg + k < ch) { Hs = a_[k] * Hs + h_[k]; As = As * a_[k]; } }
            if (cseg + 8 < ch) {
#pragma unroll
                for (int k = 0; k < 8; ++k) { a_[k] = *(const f32x4*)((const unsigned char*)(SUM + (size_t)(cseg + 8 + k) * 1024) + (unsigned)(c0 * 4)); h_[k] = *(const f32x4*)((const unsigned char*)(SUM + (size_t)(cseg + 8 + k) * 1024 + 512) + (unsigned)(c0 * 4)); }
#pragma unroll
                for (int k = 0; k < 8; ++k) { if (cseg + 8 + k < ch) { Hs = a_[k] * Hs + h_[k]; As = As * a_[k]; } } } }
        f32x4 av[16];
#pragma unroll
        for (int tt = 0; tt < 16; ++tt)
#pragma unroll
            for (int j = 0; j < 4; ++j) av[tt][j] = __builtin_amdgcn_exp2f(bf2f((unsigned short)(lu[j][tt >> 2][tt & 3] & 0xffffu)));
        __builtin_amdgcn_sched_barrier(0);
        f32x4 Aq = {1.f, 1.f, 1.f, 1.f}, Hq = {0.f, 0.f, 0.f, 0.f};
#pragma unroll
        for (int tt = 0; tt < 16; ++tt)
#pragma unroll
            for (int j = 0; j < 4; ++j) { const unsigned w = lu[j][tt >> 2][tt & 3]; const float a = av[tt][j], u = bf2f((unsigned short)(w >> 16)); Hq[j] = a * Hq[j] + u; Aq[j] *= a; }
#pragma unroll
        for (int tt = 0; tt < 16; ++tt) gy[tt] = *(const u32x2*)((const unsigned char*)(GY + (size_t)(tq + tt) * 512) + (unsigned)(c0 * 2));
        __syncthreads();
#pragma unroll
        for (int j = 0; j < 4; ++j) { qs[(q * 128 + g) * 4 + j] = (f32x2_t){Aq[j], Hq[j]}; qs[2048 + (q * 128 + g) * 4 + j] = (f32x2_t){As[j], Hs[j]}; }
        __syncthreads();
        f32x4 h = {0.f, 0.f, 0.f, 0.f};
#pragma unroll
        for (int qq = 0; qq < 4; ++qq)
#pragma unroll
            for (int j = 0; j < 4; ++j) { const f32x2_t ah = qs[2048 + (qq * 128 + g) * 4 + j]; h[j] = ah[0] * h[j] + ah[1]; }
#pragma unroll
        for (int j = 0; j < 4; ++j)
#pragma unroll
            for (int fq = 0; fq < 4; ++fq) asm volatile("" : "+v"(lu[j][fq]));
        for (int qq = 0; qq < q; ++qq) {
#pragma unroll
            for (int j = 0; j < 4; ++j) { const f32x2_t ah = qs[(qq * 128 + g) * 4 + j]; h[j] = ah[0] * h[j] + ah[1]; } }
#pragma unroll
        for (int tt = 0; tt < 16; ++tt) { f32x4 o;
#pragma unroll
            for (int j = 0; j < 4; ++j) { const unsigned w = lu[j][tt >> 2][tt & 3]; const float a = av[tt][j], u = bf2f((unsigned short)(w >> 16)); h[j] = a * h[j] + u; }
            o[0] = h[0] * bf2f((unsigned short)(gy[tt].x & 0xffffu)); o[1] = h[1] * bf2f((unsigned short)(gy[tt].x >> 16)); o[2] = h[2] * bf2f((unsigned short)(gy[tt].y & 0xffffu)); o[3] = h[3] * bf2f((unsigned short)(gy[tt].y >> 16));
            store4bf((bf16_t*)((unsigned char*)(MIX + (size_t)(tq + tt) * DM) + (unsigned)(c0 * 2)), o); }
    }
}

__device__ __forceinline__ int pi32(int r) { return (r & 0x13) | ((r & 4) << 1) | ((r & 8) >> 1); }
__device__ __forceinline__ unsigned cvtpk(float lo, float hi) { return pk2(lo, hi); }
constexpr int AT_KN = 0, AT_KR = 8192, AT_VT = 12288, AT_SLOT = 20480, AT_NSLOT = 4;
constexpr float AT_THR = 8.0f;
__device__ __forceinline__ float max3f(float a, float b, float c) { float r; asm("v_max3_f32 %0, %1, %2, %3" : "=v"(r) : "v"(a), "v"(b), "v"(c)); return r; }
#define AT_WAITV(n) asm volatile("s_waitcnt vmcnt(" #n ")" ::: "memory")
__device__ __forceinline__ void attn_unit(int wv, bool wload, int b, int h, int qb, const bf16_t* CQ, const bf16_t* WUQ, const float* SSQ, const float* TAB, const bf16_t* KN, const bf16_t* KR, const bf16_t* VT, bf16_t* MIX, LAS unsigned char* lds) {
    const int tid = otid(wv), lane = tid & 63, wid = __builtin_amdgcn_readfirstlane(tid >> 6), r32 = lane & 31, hi = lane >> 5;
    const size_t rowbase = (size_t)b * SEQ; const int q0 = qb * 256, NT = (q0 + 256) / 64;
    const int krow = 8 * wid + (lane >> 3), kch = (lane & 7) ^ ((krow >> 1) & 7);
    const bf16_t* ksrc = KN + (rowbase + krow) * 512 + h * 64 + kch * 8;
    const bf16_t* vsrc = VT + ((size_t)(b * NH + h) * VH + krow) * SEQ + kch * 8;
    const int rrow = 16 * (wid & 3) + (lane >> 2), rch = (lane & 3) ^ ((rrow >> 2) & 3);
    const bf16_t* rsrc = KR + (rowbase + rrow) * 32 + rch * 8;
    const unsigned wofs = (unsigned)wid * 1024u;
#define AT_ISSUE(t, slot) do { LAS unsigned char* sb_ = lds + (slot) * AT_SLOT; \
        __builtin_amdgcn_global_load_lds((const unsigned*)(ksrc + (size_t)(t) * 64 * 512), (LAS unsigned*)(sb_ + AT_KN + wofs), 16, 0, 0); \
        __builtin_amdgcn_global_load_lds((const unsigned*)(vsrc + (size_t)(t) * 64), (LAS unsigned*)(sb_ + AT_VT + wofs), 16, 0, 0); \
        if (wid < 4) __builtin_amdgcn_global_load_lds((const unsigned*)(rsrc + (size_t)(t) * 64 * 32), (LAS unsigned*)(sb_ + AT_KR + wofs), 16, 0, 0); } while (0)
    AT_ISSUE(0, 0); AT_ISSUE(1, 1);
    bf16x8 qf[6];
    { const size_t qrow = rowbase + q0 + 32 * wid + r32;
      if (wload) { const bf16_t* wsrc = WUQ + (size_t)h * (3 * 16 * 64 * 8) + (size_t)(wid * 6 * 64 + lane) * 8;
#pragma unroll
        for (int i = 0; i < 6; ++i) __builtin_amdgcn_global_load_lds((const unsigned*)(wsrc + (size_t)i * 512), (LAS unsigned*)(lds + AT_NSLOT * AT_SLOT + (wid * 6 + i) * 1024), 16, 0, 0); }
      bf16x8 cqf[16];
      { const bf16_t* cq = CQ + ((size_t)((rowbase + q0 + 32 * wid) >> 5) * 16 * 64 + lane) * 8;
#pragma unroll
        for (int s = 0; s < 16; ++s) cqf[s] = *(const bf16x8*)(cq + (size_t)s * 512); }
      __builtin_amdgcn_s_waitcnt(0x0F70); if (wload) __builtin_amdgcn_s_barrier(); asm volatile("" ::: "memory");
      f32x16 qa0 = {}, qa1 = {}, qa2 = {};
      const LAS unsigned char* wl = lds + AT_NSLOT * AT_SLOT + lane * 16;
#pragma unroll
      for (int s = 0; s < QLORA / 16; ++s) {
          qa0 = __builtin_amdgcn_mfma_f32_32x32x16_bf16(*(const LAS bf16x8*)(wl + (0 * 16 + s) * 1024), cqf[s], qa0, 0, 0, 0);
          qa1 = __builtin_amdgcn_mfma_f32_32x32x16_bf16(*(const LAS bf16x8*)(wl + (1 * 16 + s) * 1024), cqf[s], qa1, 0, 0, 0);
          qa2 = __builtin_amdgcn_mfma_f32_32x32x16_bf16(*(const LAS bf16x8*)(wl + (2 * 16 + s) * 1024), cqf[s], qa2, 0, 0, 0); }
      const f32x4 sa = *(const f32x4*)(SSQ + qrow * 8), sb = *(const f32x4*)(SSQ + qrow * 8 + 4);
      const float rs = __builtin_amdgcn_rsqf((((sa[0] + sa[1]) + (sa[2] + sa[3])) + ((sb[0] + sb[1]) + (sb[2] + sb[3]))) * (1.0f / QLORA) + EPS) * QSCALE;
      const f32x4* tb = (const f32x4*)(TAB + qrow * 32 + 16 * hi);
      const f32x4 c01 = tb[0], c23 = tb[1], c45 = tb[2], c67 = tb[3];
      const float cs[16] = {c01[0], c01[1], c01[2], c01[3], c23[0], c23[1], c23[2], c23[3], c45[0], c45[1], c45[2], c45[3], c67[0], c67[1], c67[2], c67[3]};
#pragma unroll
      for (int t = 0; t < 8; ++t) { const float x1 = qa2[t], x2 = qa2[t + 8], c = cs[2 * t], sn = cs[2 * t + 1]; qa2[t] = x1 * c - x2 * sn; qa2[t + 8] = x2 * c + x1 * sn; }
#define AT_QPK(A, o) __builtin_bit_cast(bf16x8, (u32x4){pk2(A[(o)] * rs, A[(o) + 1] * rs), pk2(A[(o) + 2] * rs, A[(o) + 3] * rs), pk2(A[(o) + 4] * rs, A[(o) + 5] * rs), pk2(A[(o) + 6] * rs, A[(o) + 7] * rs)})
      qf[0] = AT_QPK(qa0, 0); qf[1] = AT_QPK(qa0, 8); qf[2] = AT_QPK(qa1, 0); qf[3] = AT_QPK(qa1, 8); qf[4] = AT_QPK(qa2, 0); qf[5] = AT_QPK(qa2, 8);
#undef AT_QPK
    }
    __builtin_amdgcn_s_waitcnt(0x0F70);
    const int pr = pi32(r32);
    int kno[2], kro[2], vto[2];
#pragma unroll
    for (int hf = 0; hf < 2; ++hf) { const int row = 32 * hf + pr; kno[hf] = AT_KN + row * 128 + ((hi ^ ((row >> 1) & 7)) << 4); kro[hf] = AT_KR + row * 64 + ((hi ^ ((row >> 2) & 3)) << 4);
        const int dr = 32 * hf + r32; vto[hf] = AT_VT + dr * 128 + ((hi ^ ((dr >> 1) & 7)) << 4); }
    f32x16 o0 = {}, o1 = {}, negm = {}; float m = 0.f, lsum = 0.f; bool first = true;
    const int qg = q0 + 32 * wid + r32; const unsigned lds_base = (unsigned)(size_t)lds;
    for (int tp = 0; tp < NT; tp += 2) {
        AT_WAITV(0);
        __builtin_amdgcn_s_barrier(); asm volatile("" ::: "memory");
        if (tp + 2 < NT) { const int sn = 2 * (((tp >> 1) + 1) & 1); AT_ISSUE(tp + 2, sn); AT_ISSUE(tp + 3, sn + 1); }
#pragma unroll 1
      for (int sub = 0; sub < 2; ++sub) {
        const int t = tp + sub, slot = 2 * ((tp >> 1) & 1) + sub;
        const int kv0 = 64 * t;
        if (kv0 <= q0 + 32 * wid + 31) {
            const unsigned sba = lds_base + (unsigned)slot * AT_SLOT;
            bf16x8 kf[12], vf[8];
#define AT_DSR(dst, addr, off) asm volatile("ds_read_b128 %0, %1 offset:%2" : "=v"(dst) : "v"(addr), "i"(off))
#pragma unroll
            for (int s = 0; s < 4; ++s) { const unsigned ka = sba + (unsigned)(kno[0] ^ (s << 5)); AT_DSR(kf[2 * s], ka, 0); AT_DSR(kf[2 * s + 1], ka, 4096); }
#pragma unroll
            for (int s = 0; s < 2; ++s) { const unsigned ka = sba + (unsigned)(kro[0] ^ (s << 5)); AT_DSR(kf[8 + 2 * s], ka, 0); AT_DSR(kf[8 + 2 * s + 1], ka, 2048); }
            f32x16 st0, st1;
#define AT_KSTEP(s, n) do { asm volatile("s_waitcnt lgkmcnt(" #n ")" : "+v"(kf[2 * (s)]), "+v"(kf[2 * (s) + 1])); __builtin_amdgcn_sched_barrier(0); \
                st0 = __builtin_amdgcn_mfma_f32_32x32x16_bf16(kf[2 * (s)], qf[s], st0, 0, 0, 0); st1 = __builtin_amdgcn_mfma_f32_32x32x16_bf16(kf[2 * (s) + 1], qf[s], st1, 0, 0, 0); } while (0)
            { asm volatile("s_waitcnt lgkmcnt(10)" : "+v"(kf[0]), "+v"(kf[1])); __builtin_amdgcn_sched_barrier(0);
              st0 = __builtin_amdgcn_mfma_f32_32x32x16_bf16(kf[0], qf[0], negm, 0, 0, 0); st1 = __builtin_amdgcn_mfma_f32_32x32x16_bf16(kf[1], qf[0], negm, 0, 0, 0); }
            AT_KSTEP(1, 8); AT_KSTEP(2, 6); AT_KSTEP(3, 4); AT_KSTEP(4, 2); AT_KSTEP(5, 0);
            asm volatile("s_nop 15\n\ts_nop 7" : "+v"(st0), "+v"(st1));
#pragma unroll
            for (int ks = 0; ks < 4; ++ks) { const unsigned va = sba + (unsigned)(vto[0] ^ (ks << 5)); AT_DSR(vf[2 * ks], va, 0); AT_DSR(vf[2 * ks + 1], va, 4096); }
            if (kv0 + 63 > q0 + 32 * wid) {
                const int dq = qg - kv0 - 8 * hi;
#pragma unroll
                for (int reg = 0; reg < 16; ++reg) { const int cb = (reg & 3) + 4 * ((reg >> 2) & 1) + 16 * (reg >> 3); if (cb > dq) st0[reg] = -INFINITY; if (cb + 32 > dq) st1[reg] = -INFINITY; }
            }
            float mx = max3f(st0[0], st0[1], st1[0]), mx2 = max3f(st0[2], st0[3], st1[1]); mx = max3f(mx, st1[2], st1[3]);
#pragma unroll
            for (int reg = 4; reg < 16; reg += 4) { mx = max3f(mx, st0[reg], st0[reg + 1]); mx2 = max3f(mx2, st0[reg + 2], st0[reg + 3]); mx = max3f(mx, st1[reg], st1[reg + 1]); mx2 = max3f(mx2, st1[reg + 2], st1[reg + 3]); }
            mx = max3f(mx, mx2, mx2);
            { const auto rr = __builtin_amdgcn_permlane32_swap(__float_as_uint(mx), __float_as_uint(mx), false, false); mx = max3f(__uint_as_float(rr[0]), __uint_as_float(rr[1]), __uint_as_float(rr[1])); }
            if (first || __any(mx > AT_THR)) {
                const float dl = first ? mx : fmaxf(mx, 0.f); const float alpha = first ? 0.f : __builtin_amdgcn_exp2f(-dl); first = false; m += dl; lsum *= alpha;
#pragma unroll
                for (int reg = 0; reg < 16; ++reg) { st0[reg] -= dl; st1[reg] -= dl; o0[reg] *= alpha; o1[reg] *= alpha; negm[reg] = -m; }
            }
            float ps = 0.f;
#pragma unroll
            for (int reg = 0; reg < 16; ++reg) { st0[reg] = __builtin_amdgcn_exp2f(st0[reg]); st1[reg] = __builtin_amdgcn_exp2f(st1[reg]); ps += st0[reg] + st1[reg]; }
            lsum += ps;
            u32x4 pw[4];
#pragma unroll
            for (int q = 0; q < 4; ++q) { pw[0][q] = cvtpk(st0[2 * q], st0[2 * q + 1]); pw[1][q] = cvtpk(st0[8 + 2 * q], st0[8 + 2 * q + 1]); pw[2][q] = cvtpk(st1[2 * q], st1[2 * q + 1]); pw[3][q] = cvtpk(st1[8 + 2 * q], st1[8 + 2 * q + 1]); }
#define AT_VSTEP(ks, n) do { asm volatile("s_waitcnt lgkmcnt(" #n ")" : "+v"(vf[2 * (ks)]), "+v"(vf[2 * (ks) + 1])); __builtin_amdgcn_sched_barrier(0); const bf16x8 pb = __builtin_bit_cast(bf16x8, pw[ks]); \
                o0 = __builtin_amdgcn_mfma_f32_32x32x16_bf16(vf[2 * (ks)], pb, o0, 0, 0, 0); o1 = __builtin_amdgcn_mfma_f32_32x32x16_bf16(vf[2 * (ks) + 1], pb, o1, 0, 0, 0); } while (0)
            AT_VSTEP(0, 6); AT_VSTEP(1, 4); AT_VSTEP(2, 2); AT_VSTEP(3, 0);
#undef AT_DSR
#undef AT_KSTEP
#undef AT_VSTEP
        }
        asm volatile("s_waitcnt lgkmcnt(0)" ::: "memory");
      }
    }
    { const auto rr = __builtin_amdgcn_permlane32_swap(__float_as_uint(lsum), __float_as_uint(lsum), false, false); lsum = __uint_as_float(rr[0]) + __uint_as_float(rr[1]); }
    const float il = 1.0f / lsum; bf16_t* op = MIX + (rowbase + q0 + 32 * wid + r32) * DM + 512 + h * VH;
#pragma unroll
    for (int g = 0; g < 4; ++g) { const int dd = 8 * g + 4 * hi;
        store4bf(op + dd, (f32x4){o0[4 * g] * il, o0[4 * g + 1] * il, o0[4 * g + 2] * il, o0[4 * g + 3] * il});
        store4bf(op + 32 + dd, (f32x4){o1[4 * g] * il, o1[4 * g + 1] * il, o1[4 * g + 2] * il, o1[4 * g + 3] * il}); }
    AT_WAITV(0);
    __builtin_amdgcn_s_barrier(); asm volatile("" ::: "memory");
#undef AT_ISSUE
}
__device__ __forceinline__ void attn_phase(PP p, int wv, int l, int bid, int nb, unsigned char* smem) {
    unsigned char* ws = p->ws;
    const bf16_t* CQ = (const bf16_t*)(ws + WS_CQF); const bf16_t* WUQ = (const bf16_t*)(ws + WS_WUQ) + (size_t)l * QW * QLORA; const float* SSQ = (const float*)(ws + WS_SSQ); const float* TAB = (const float*)(ws + WS_TAB); const bf16_t* KN = (const bf16_t*)(ws + WS_KF); const bf16_t* KR = (const bf16_t*)(ws + WS_KR); const bf16_t* VT = (const bf16_t*)(ws + WS_VT); bf16_t* MIX = (bf16_t*)(ws + WS_MIX);
    const int vcu = (nb % 8 == 0) ? (bid % 8) * (nb / 8) + bid / 8 : bid;
    for (int pr = vcu; pr < BATCH * NH * 8; pr += nb) {
        const int bh = pr >> 3, s = pr & 7;
        attn_unit(wv, true, bh / NH, bh % NH, 15 - s, CQ, WUQ, SSQ, TAB, KN, KR, VT, MIX, (LAS unsigned char*)smem);
        attn_unit(wv, false, bh / NH, bh % NH, s, CQ, WUQ, SSQ, TAB, KN, KR, VT, MIX, (LAS unsigned char*)smem);
    }
}

__device__ void router_phase(PP p, int wv, int bid, int nb, unsigned char* smem) {
    const int tid = otid(wv), lane = tid & 63, wid = tid >> 6;
    unsigned char* ws = p->ws; const bf16_t* X = (const bf16_t*)(ws + WS_XB); int* cnt = (int*)(ws + WS_CTL);
    int* RTF = (int*)(ws + WS_RTF); float* RWF = (float*)(ws + WS_RWF); int* RSF = (int*)(ws + WS_RSF); float* RRSF = (float*)(ws + WS_RRSF);
    int* se = (int*)smem;
    float* sw = (float*)(smem + 1024);
    const float* g = p->norm_ffn + DM; const float* rw = p->router_w;
    f32x4 wlo[4][4], whi[4][4];
#pragma unroll
    for (int j = 0; j < 4; ++j) { const f32x4 gv = *(const f32x4*)(g + 256 * j + 4 * lane);
#pragma unroll
        for (int q = 0; q < 4; ++q) { const float* w = rw + (size_t)(256 * j + 4 * lane + q) * NE; wlo[j][q] = *(const f32x4*)w * gv[q]; whi[j][q] = *(const f32x4*)(w + 4) * gv[q]; } }
    for (int grp = bid; grp < T / 64; grp += nb) {
        for (int i = 0; i < 8; ++i) {
            const int t = grp * 64 + wid * 8 + i; const bf16_t* xr = X + (size_t)t * DM;
            float acc[NE]; float ss = 0.f;
#pragma unroll
            for (int e = 0; e < NE; ++e) acc[e] = 0.f;
            u32x2 xw[4];
#pragma unroll
            for (int j = 0; j < 4; ++j) xw[j] = *(const u32x2*)(xr + 256 * j + 4 * lane);
#pragma unroll
            for (int j = 0; j < 4; ++j) { const f32x4 xv = {bf2f(xw[j].x & 0xffff), bf2f(xw[j].x >> 16), bf2f(xw[j].y & 0xffff), bf2f(xw[j].y >> 16)};
#pragma unroll
                for (int q = 0; q < 4; ++q) { const float xs = xv[q]; ss += xs * xs; const f32x4 w0 = wlo[j][q], w1 = whi[j][q];
                    acc[0] += xs * w0[0]; acc[1] += xs * w0[1]; acc[2] += xs * w0[2]; acc[3] += xs * w0[3]; acc[4] += xs * w1[0]; acc[5] += xs * w1[1]; acc[6] += xs * w1[2]; acc[7] += xs * w1[3]; } }
            ss = wave_sum(ss, lane);
#pragma unroll
            for (int e = 0; e < NE; ++e) acc[e] = wave_sum(acc[e], lane);
            const float rs = rsqrtf(ss * (1.0f / DM) + EPS);
            int e1 = 0; float l1 = acc[0];
#pragma unroll
            for (int e = 1; e < NE; ++e) if (acc[e] > l1) { l1 = acc[e]; e1 = e; }
            int e2 = -1; float l2 = -INFINITY;
#pragma unroll
            for (int e = 0; e < NE; ++e) if (e != e1 && acc[e] > l2) { l2 = acc[e]; e2 = e; }
            const float w2 = 1.f / (1.f + expf((l1 - l2) * rs)), w1 = 1.f - w2;
            if (lane == 0) { se[2 * (wid * 8 + i)] = e1; se[2 * (wid * 8 + i) + 1] = e2; sw[3 * (wid * 8 + i)] = w1; sw[3 * (wid * 8 + i) + 1] = w2; sw[3 * (wid * 8 + i) + 2] = rs; }
        }
        __syncthreads();
        if (wid == 0) {
            const int t = grp * 64 + lane, e1 = se[2 * lane], e2 = se[2 * lane + 1]; int r1 = 0, r2 = 0;
            for (int e = 0; e < NE; ++e) {
                const unsigned long long m1 = __ballot(e1 == e), m2 = __ballot(e2 == e);
                const int c1 = __popcll(m1), c2 = __popcll(m2);
                int base = 0; if (lane == 0 && (c1 + c2) > 0) base = atomicAdd(cnt + e, c1 + c2);
                base = __builtin_amdgcn_readfirstlane(base);
                const unsigned long long below = (lane == 0) ? 0ull : (~0ull >> (64 - lane));
                if (e1 == e) r1 = base + __popcll(m1 & below);
                if (e2 == e) r2 = base + c1 + __popcll(m2 & below);
            }
            { const int f1 = e1 * T + r1, f2 = e2 * T + r2; const float rs_ = sw[3 * lane + 2];
              RTF[f1] = t; RWF[f1] = sw[3 * lane]; RSF[f1] = 2 * t; RRSF[f1] = rs_; RTF[f2] = t; RWF[f2] = sw[3 * lane + 1]; RSF[f2] = 2 * t + 1; RRSF[f2] = rs_; }
        }
        __syncthreads();
    }
}
__device__ void gc_phase(PP p, int wv, int bid, int nb) {
    unsigned char* ws = p->ws; const int* cnt = (const int*)(ws + WS_CTL); int off[NE + 1]; expert_offsets(cnt, off);
    const int* TOPE = (const int*)(ws + WS_TOPE); const float* TOPW = (const float*)(ws + WS_TOPW); const int* RANK = (const int*)(ws + WS_RANK);
    int* rt = (int*)(ws + WS_ROWTOK); float* rw = (float*)(ws + WS_ROWW); int* rs = (int*)(ws + WS_ROWSLOT);
    for (int i = bid * NTHR + otid(wv); i < 2 * T; i += nb * NTHR) {
        const int e = TOPE[i]; int o = 0;
#pragma unroll
        for (int q = 0; q < NE; ++q) if (q == e) o = off[q];
        const int pos = o + RANK[i]; rt[pos] = i >> 1; rw[pos] = TOPW[i]; rs[pos] = i; ((float*)(ws + WS_ROWRS))[pos] = ((const float*)(ws + WS_RSTOK))[i >> 1];
    }
}
__device__ __forceinline__ void egu_phase(PP p, int wv, int bid, int nb, unsigned char* smem) {
    unsigned char* ws = p->ws; const int* cnt = (const int*)(ws + WS_CTL); int off[NE + 1]; expert_offsets(cnt, off);
    pg8::Gemm g{(const bf16_t*)(ws + WS_XB8), (const bf16_t*)(ws + WS_EGU), DM / 2, DM / 2, DM / 2, (const int*)(ws + WS_RTF)};
    pg8::GroupedOrder S; S.so.init(off[NE] / 256, (2 * DFE) / 256, nb, bid); S.o1 = off[1]; S.o2 = off[2]; S.o3 = off[3]; S.o4 = off[4]; S.o5 = off[5]; S.o6 = off[6]; S.o7 = off[7];
    pg8::EpiW<EpiGU<true>> E{EpiGU<true>{(const float*)(ws + WS_RRSF), nullptr, (bf16_t*)(ws + WS_ACT), DFE}, (2 * DFE) / 256};
    pg8::gemm_phase<pg8::EpiW<EpiGU<true>>, pg8::GroupedOrder, true, true, true>(wv, (PG8_LAS unsigned char*)smem, g, S, E);
}
__device__ __forceinline__ void ed_phase(PP p, int wv, int bid, int nb, unsigned char* smem) {
    unsigned char* ws = p->ws; const int* cnt = (const int*)(ws + WS_CTL); int off[NE + 1]; expert_offsets(cnt, off);
    pg8::Gemm g{(const bf16_t*)(ws + WS_ACT), (const bf16_t*)(ws + WS_ED), DFE / 2, DFE / 2, DFE / 2, nullptr};
    pg8::GroupedOrder S; S.so.init(off[NE] / 256, DM / 256, nb, bid); S.o1 = off[1]; S.o2 = off[2]; S.o3 = off[3]; S.o4 = off[4]; S.o5 = off[5]; S.o6 = off[6]; S.o7 = off[7];
    pg8::EpiW<EpiED> E{EpiED{(const float*)(ws + WS_RWF), (const int*)(ws + WS_RSF), (bf16_t*)(ws + WS_Y)}, DM / 256};
    pg8::gemm_phase<pg8::EpiW<EpiED>, pg8::GroupedOrder, true, false, true>(wv, (PG8_LAS unsigned char*)smem, g, S, E);
}
__device__ void final_phase(PP p, int wv, int bid, int nb) {
    const int tid_ = otid(wv); const int lane = tid_ & 63, wid = tid_ >> 6; const unsigned char* Y = (const unsigned char*)(p->ws + WS_Y);
    for (int t = bid * NWAVE + wid; t < T; t += nb * NWAVE) {
        float* xr = p->out + (size_t)t * DM; const bf16_t* xb = (const bf16_t*)(p->ws + WS_XB) + (size_t)t * DM; f32x4 v[4]; unsigned ya[4], yb[4]; float ss = 0.f;
#pragma unroll
        for (int j = 0; j < 4; ++j) { { const u32x2 xw = __builtin_nontemporal_load((const u32x2*)(xb + 256 * j + 4 * lane)); v[j] = (f32x4){bf2f(xw.x & 0xffff), bf2f(xw.x >> 16), bf2f(xw.y & 0xffff), bf2f(xw.y >> 16)}; }
            ya[j] = __builtin_nontemporal_load((const unsigned*)(Y + (size_t)(2 * t) * DM + 256 * j + 4 * lane)); yb[j] = __builtin_nontemporal_load((const unsigned*)(Y + (size_t)(2 * t + 1) * DM + 256 * j + 4 * lane)); }
#pragma unroll
        for (int j = 0; j < 4; ++j) { const auto a01 = __builtin_amdgcn_cvt_pk_f32_fp8((int)ya[j], false), a23 = __builtin_amdgcn_cvt_pk_f32_fp8((int)ya[j], true), b01 = __builtin_amdgcn_cvt_pk_f32_fp8((int)yb[j], false), b23 = __builtin_amdgcn_cvt_pk_f32_fp8((int)yb[j], true);
            v[j][0] += (a01[0] + b01[0]) * (1.0f / F8_YS); v[j][1] += (a01[1] + b01[1]) * (1.0f / F8_YS); v[j][2] += (a23[0] + b23[0]) * (1.0f / F8_YS); v[j][3] += (a23[1] + b23[1]) * (1.0f / F8_YS);
            ss += (v[j][0] * v[j][0] + v[j][1] * v[j][1]) + (v[j][2] * v[j][2] + v[j][3] * v[j][3]); }
        ss = wave_sum(ss, lane); const float rs = __builtin_amdgcn_rsqf(ss * (1.0f / DM) + EPS);
#pragma unroll
        for (int j = 0; j < 4; ++j) { const f32x4 g = *(const f32x4*)(p->norm_final + 256 * j + 4 * lane); __builtin_nontemporal_store(v[j] * rs * g, (f32x4*)(xr + 256 * j + 4 * lane)); }
    }
}

enum { K_P0, K_GIN, K_LRUSUM, K_GQ, K_GKV, K_ATTN, K_LRUFIN, K_GOUT, K_FUP, K_FDOWN, K_ROUTER, K_GC, K_EGU, K_ED, K_FINAL };
template <int KIND>
__device__ __forceinline__ void run_kind(PP p, int wv, int l, int bid, int nb, unsigned char* smem) {
    unsigned char* ws = p->ws;
    if constexpr (KIND == K_P0) phase_p0(p, wv, bid, nb, smem);
    else if constexpr (KIND == K_GIN) {
        EpiIn E{(const float*)(ws + WS_SSX), (bf16_t*)(ws + WS_XL), (bf16_t*)(ws + WS_GY), (bf16_t*)(ws + WS_CQ), (bf16_t*)(ws + WS_KR), (float*)(ws + WS_SSQ), (float*)(ws + WS_SSKV), (const float*)(ws + WS_TAB), (bf16_t*)(ws + WS_CQF)};
        gemm_static<EpiIn, true>(wv, (const bf16_t*)(ws + WS_XB), DM, (const bf16_t*)(ws + WS_WIN) + (size_t)l * INCP * DM, DM, T, INCP, DM, E, bid, nb, smem);
    } else if constexpr (KIND == K_LRUSUM) lru_sum_phase(p, wv, l, bid, nb, smem);
    else if constexpr (KIND == K_GQ) {
    } else if constexpr (KIND == K_GKV) {
        EpiKV EK{(const float*)(ws + WS_SSKV), (bf16_t*)(ws + WS_KF), (bf16_t*)(ws + WS_VT)};
        int kk = KVLORA; asm volatile("" : "+s"(kk));
        gemm_static<EpiKV, true>(wv, (const bf16_t*)(ws + WS_CQ) + 256, 384, (const bf16_t*)(ws + WS_WUKV) + (size_t)l * KVW * 256 + 128, 256, T, KVW, kk, EK, bid, nb, smem);
    } else if constexpr (KIND == K_ATTN) attn_phase(p, wv, l, bid, nb, smem);
    else if constexpr (KIND == K_LRUFIN) lru_scan_phase(p, wv, bid, nb, smem);
    else if constexpr (KIND == K_GOUT) {
        EpiRes E{(bf16_t*)(ws + WS_XB), l == 1 ? ws + WS_XB8 : nullptr, (float*)(ws + WS_SSX), 1.0f};
        gemm_static<EpiRes, true>(wv, (const bf16_t*)(ws + WS_MIX), DM, (const bf16_t*)(ws + WS_WOUT) + (size_t)l * DM * DM, DM, T, DM, DM, E, bid, nb, smem);
    } else if constexpr (KIND == K_FUP) {
        EpiGU<false> E{(const float*)(ws + WS_SSX), nullptr, (bf16_t*)(ws + WS_ACT), DFF};
        gemm_static<EpiGU<false>, true>(wv, (const bf16_t*)(ws + WS_XB), DM, (const bf16_t*)(ws + WS_WGU), DM, T, 2 * DFF, DM, E, bid, nb, smem);
    } else if constexpr (KIND == K_FDOWN) {
        EpiRes E{(bf16_t*)(ws + WS_XB), nullptr, (float*)(ws + WS_SSX), 1.0f};
        gemm_static<EpiRes, true>(wv, (const bf16_t*)(ws + WS_ACT), DFF, (const bf16_t*)(ws + WS_WD), DFF, T, DM, DFF, E, bid, nb, smem);
    } else if constexpr (KIND == K_ROUTER) router_phase(p, wv, bid, nb, smem);
    else if constexpr (KIND == K_GC) gc_phase(p, wv, bid, nb);
    else if constexpr (KIND == K_EGU) egu_phase(p, wv, bid, nb, smem);
    else if constexpr (KIND == K_ED) ed_phase(p, wv, bid, nb, smem);
    else final_phase(p, wv, bid, nb);
}

constexpr int LDS_BYTES = 163840;
template <int KIND>
__global__ void __launch_bounds__(NTHR) k_phase(P p, int l) {
    extern __shared__ __attribute__((aligned(16))) unsigned char smem[];
    run_kind<KIND>((PP)__builtin_amdgcn_kernarg_segment_ptr(), __builtin_amdgcn_readfirstlane((int)threadIdx.x >> 6), l, (int)blockIdx.x, (int)gridDim.x, smem);
}
template <int KIND> static void launch_kind(PP p, int l, int grid, hipStream_t stream) {
    static bool attr = false;
    if (!attr) { (void)hipFuncSetAttribute((const void*)k_phase<KIND>, hipFuncAttributeMaxDynamicSharedMemorySize, LDS_BYTES); attr = true; }
    hipLaunchKernelGGL(k_phase<KIND>, dim3(grid), dim3(NTHR), LDS_BYTES, stream, p, l);
}

#define XB_TMO      128
#define XB_XCNT(j)  (256  + 64 * (j))
#define XB_XSUB(j)  (1280 + 64 * (j))
#define XB_XGEN(j)  (2304 + 64 * (j))
#define XB_TOP      3328
#define XB_TOPGEN   3392
#define XCD_BAR_WORDS 3456
#define XB_SPIN_CAP (1u << 18)

__device__ __forceinline__ unsigned xb_ld(unsigned* p)              { return __hip_atomic_load(p, __ATOMIC_RELAXED, __HIP_MEMORY_SCOPE_AGENT); }
__device__ __forceinline__ unsigned xb_add(unsigned* p, unsigned v) { return __hip_atomic_fetch_add(p, v, __ATOMIC_RELAXED, __HIP_MEMORY_SCOPE_AGENT); }
__device__ __forceinline__ unsigned xb_xcc_id() { return (unsigned)__builtin_amdgcn_s_getreg((3 << 11) | 20) & 0xFu; }
#define XB_SPIN(cond, bar) do { unsigned _sp = 0; while (cond) { __builtin_amdgcn_s_sleep(1); \
    if ((++_sp & 255u) == 0u) { if (xb_ld(&(bar)[XB_TMO])) break; if (_sp > XB_SPIN_CAP) { atomicAdd(&(bar)[XB_TMO], 1u); break; } } } } while (0)

struct XcdBarrier {
    unsigned* bar; unsigned x;
    volatile LAS unsigned* st;
};

__device__ __forceinline__ XcdBarrier xcd_barrier_post(unsigned* bar, volatile LAS unsigned* st, bool leader) {
    XcdBarrier b; b.bar = bar; b.x = xb_xcc_id(); b.st = st;
    if (leader) (void)xb_add(&bar[XB_XCNT(b.x)], 1u);
    return b;
}
__device__ __forceinline__ void xcd_barrier_complete(unsigned* bar, unsigned x, unsigned& nloc, unsigned& nx) {
    const unsigned G = gridDim.x * gridDim.y * gridDim.z;
    unsigned sum, cnt, mine, sp = 0u;
    for (;;) {
        sum = 0u; cnt = 0u; mine = 0u;
#pragma unroll
        for (unsigned j = 0; j < 16; ++j) { const unsigned c = xb_ld(&bar[XB_XCNT(j)]); sum += c; cnt += (c > 0u) ? 1u : 0u; mine = (j == x) ? c : mine; }
        if (sum == G) break;
        __builtin_amdgcn_s_sleep(1);
        if ((++sp & 255u) == 0u) { if (xb_ld(&bar[XB_TMO])) break; if (sp > XB_SPIN_CAP) { atomicAdd(&bar[XB_TMO], 1u); break; } }
    }
    nloc = mine > 0u ? mine : 1u; nx = cnt > 0u ? cnt : 1u;
}

__device__ __forceinline__ void xcd_barrier(const XcdBarrier& b, bool leader) {
    asm volatile("s_waitcnt vmcnt(0)" ::: "memory");
    __syncthreads();
    if (leader) {
        unsigned* bar = b.bar;
        __builtin_amdgcn_s_waitcnt(0);
        unsigned nloc = b.st[0], nx = b.st[1];
        if (nloc == 0u) { xcd_barrier_complete(bar, b.x, nloc, nx); b.st[0] = nloc; b.st[1] = nx; }
        const unsigned old = xb_add(&bar[XB_XSUB(b.x)], 1u);
        const unsigned gen = old / nloc;
        if (old + 1u == (gen + 1u) * nloc) {
            asm volatile("buffer_inv sc1" ::: "memory");
            __builtin_amdgcn_fence(__ATOMIC_RELEASE, "agent");
            asm volatile("s_waitcnt vmcnt(0)" ::: "memory");
            const unsigned og = xb_add(&bar[XB_TOP], 1u);
            const unsigned tg = og / nx;
            if (og + 1u == (tg + 1u) * nx) xb_add(&bar[XB_TOPGEN], 1u);
            else XB_SPIN(xb_ld(&bar[XB_TOPGEN]) == tg, bar);
            xb_add(&bar[XB_XGEN(b.x)], 1u);
            asm volatile("s_waitcnt vmcnt(0)" ::: "memory");
        } else {
            asm volatile("buffer_inv sc1" ::: "memory");
            XB_SPIN(xb_ld(&bar[XB_XGEN(b.x)]) == gen, bar);
            asm volatile("s_waitcnt vmcnt(0)" ::: "memory");
        }
    }
    __syncthreads();
}


#if MK_MODE != 0
__global__ void __launch_bounds__(NTHR) mk_fused(P p_arg) {
    extern __shared__ __attribute__((aligned(16))) unsigned char smem[];
    const int bid0 = (int)blockIdx.x, nb0 = (int)gridDim.x;
    const PP kp = (PP)__builtin_amdgcn_kernarg_segment_ptr();
    const int wv = __builtin_amdgcn_readfirstlane((int)threadIdx.x >> 6);
    volatile LAS unsigned* misc = (volatile LAS unsigned*)((LAS unsigned char*)smem + MISC_OFF);
    if (threadIdx.x < 64) misc[threadIdx.x] = 0u;
    __syncthreads();
    (void)xcd_barrier_post((unsigned*)(kp->ws + WS_CTL) + CW_BAR, misc + 8, threadIdx.x == 0);
#define GRID_BAR() do { PP kq_ = kp; asm volatile("" : "+s"(kq_)); XcdBarrier b_; b_.bar = (unsigned*)(kq_->ws + WS_CTL) + CW_BAR; b_.x = xb_xcc_id(); b_.st = (volatile LAS unsigned*)((LAS unsigned char*)smem + MISC_OFF) + 8; \
        xcd_barrier(b_, otid(wv) == 0); } while (0)
#ifndef PROBE_DUP
#define PROBE_DUP -1
#endif
#define DUP(k, stmt) do { PP p = kp; int bid = bid0, nb = nb0; asm volatile("" : "+s"(p), "+s"(bid), "+s"(nb)); stmt; if (PROBE_DUP == (k)) { GRID_BAR(); stmt; } } while (0)
    DUP(0, run_kind<K_P0>(p, wv, 0, bid, nb, smem)); GRID_BAR();
#pragma unroll 1
    for (int l = 0; l < DEPTH; ++l) {
        DUP(1, run_kind<K_GIN>(p, wv, l, bid, nb, smem)); GRID_BAR();
        DUP(4, run_kind<K_GKV>(p, wv, l, bid, nb, smem)); __syncthreads(); DUP(-2, run_kind<K_LRUSUM>(p, wv, l, bid, nb, smem)); GRID_BAR();
        DUP(-2, run_kind<K_LRUFIN>(p, wv, l, bid, nb, smem)); __syncthreads(); DUP(5, run_kind<K_ATTN>(p, wv, l, bid, nb, smem)); GRID_BAR();
        DUP(-2, run_kind<K_GOUT>(p, wv, l, bid, nb, smem)); GRID_BAR();
        if (l == 0) { DUP(7, run_kind<K_FUP>(p, wv, l, bid, nb, smem)); GRID_BAR(); DUP(-2, run_kind<K_FDOWN>(p, wv, l, bid, nb, smem)); GRID_BAR(); }
    }
    DUP(-2, run_kind<K_ROUTER>(p, wv, 1, bid, nb, smem)); GRID_BAR();
    DUP(9, run_kind<K_EGU>(p, wv, 1, bid, nb, smem)); GRID_BAR();
    DUP(10, run_kind<K_ED>(p, wv, 1, bid, nb, smem)); GRID_BAR();
    DUP(-2, run_kind<K_FINAL>(p, wv, 1, bid, nb, smem));
#undef DUP
#undef GRID_BAR
}

#endif
extern "C" void kernel_launch(void* const* d_in, const int* in_sizes, int n_in, void* d_out, int out_size, void* d_ws, size_t ws_size, hipStream_t stream) {
    if (n_in != 25 || out_size != T * DM || ws_size < WS_END) { fprintf(stderr, "kernel_launch: unexpected shapes (n_in %d, out %d, ws %zu)\n", n_in, out_size, ws_size); return; }
    P p{};
    p.x = (const float*)d_in[0]; p.positions = (const int*)d_in[1]; p.norm_mix = (const float*)d_in[2]; p.w_in = (const float*)d_in[3]; p.conv_w = (const float*)d_in[4]; p.conv_b = (const float*)d_in[5];
    p.lru_wa = (const float*)d_in[6]; p.lru_ba = (const float*)d_in[7]; p.lru_wx = (const float*)d_in[8]; p.lru_bx = (const float*)d_in[9]; p.lru_lambda = (const float*)d_in[10]; p.q_norm = (const float*)d_in[11];
    p.w_uq = (const float*)d_in[12]; p.kv_norm = (const float*)d_in[13]; p.w_ukv = (const float*)d_in[14]; p.w_out = (const float*)d_in[15]; p.norm_ffn = (const float*)d_in[16];
    p.dense_w_gate = (const float*)d_in[17]; p.dense_w_up = (const float*)d_in[18]; p.dense_w_down = (const float*)d_in[19]; p.router_w = (const float*)d_in[20];
    p.expert_w_gate = (const float*)d_in[21]; p.expert_w_up = (const float*)d_in[22]; p.expert_w_down = (const float*)d_in[23]; p.norm_final = (const float*)d_in[24];
    p.out = (float*)d_out; p.ws = (unsigned char*)d_ws;
#if MK_MODE == 0
    const int G = 1024;
    launch_kind<K_P0>(p, 0, G, stream);
    for (int l = 0; l < DEPTH; ++l) {
        launch_kind<K_GIN>(p, l, G, stream);
        launch_kind<K_LRUSUM>(p, l, 256, stream); launch_kind<K_GQ>(p, l, G, stream); launch_kind<K_GKV>(p, l, G, stream);
        launch_kind<K_ATTN>(p, l, G, stream); launch_kind<K_LRUFIN>(p, l, 256, stream);
        launch_kind<K_GOUT>(p, l, G, stream);
        if (l == 0) { launch_kind<K_FUP>(p, l, G, stream); launch_kind<K_FDOWN>(p, l, G, stream); }
        else { launch_kind<K_ROUTER>(p, l, 256, stream); launch_kind<K_GC>(p, l, 64, stream); launch_kind<K_EGU>(p, l, G, stream); launch_kind<K_ED>(p, l, G, stream); launch_kind<K_FINAL>(p, l, G, stream); }
    }
#else
    static int grid_blocks = 0;
    if (!grid_blocks) {
        int dev = 0, cus = 0, per_cu = 0;
        (void)hipGetDevice(&dev); (void)hipDeviceGetAttribute(&cus, hipDeviceAttributeMultiprocessorCount, dev);
        (void)hipFuncSetAttribute((const void*)mk_fused, hipFuncAttributeMaxDynamicSharedMemorySize, LDS_BYTES);
        (void)hipOccupancyMaxActiveBlocksPerMultiprocessor(&per_cu, (const void*)mk_fused, NTHR, LDS_BYTES);
        if (per_cu < 1) { fprintf(stderr, "kernel_launch: occupancy query says %d blocks/CU\n", per_cu); per_cu = 1; }
        grid_blocks = cus * 1;
    }
    (void)hipMemsetAsync((char*)d_ws + WS_CTL, 0, CTL_ZERO_BYTES, stream);
    void* args[] = {&p};
    hipError_t e = hipLaunchCooperativeKernel((const void*)mk_fused, dim3(grid_blocks), dim3(NTHR), args, LDS_BYTES, stream);
    if (e != hipSuccess) fprintf(stderr, "cooperative launch failed: %s (grid %d)\n", hipGetErrorString(e), grid_blocks);
#endif
}
```
